# Optimizing an MI355X kernel written in HIP

```python
import jax, jax.numpy as jnp
from jax import lax
import numpy as np

D_MODEL = 4096
BATCH = 4
SEQ = 4096
DEPTH = 1

EPS = 1e-6
PLE_DIM = 256
MLA_HEADS = 16
QK_NOPE = 128
QK_ROPE = 64
QK_HEAD = QK_NOPE + QK_ROPE
V_HEAD = 128
Q_LORA = 768
KV_LORA = 512
ROPE_THETA = 10000.0
Q_BLOCK = 128
HG_HEADS = 16
HG_EXPAND = 128
HG_HEAD_V = 128
HG_FDIM = HG_HEADS * HG_EXPAND
HG_VDIM = HG_HEADS * HG_HEAD_V
CHUNK = 64
MIX_WIDTH = MLA_HEADS * V_HEAD + HG_VDIM
D_FF = 4 * D_MODEL
IN_WIDTH = Q_LORA + KV_LORA + QK_ROPE + HG_FDIM + HG_FDIM + HG_VDIM + HG_VDIM
IN_SPLITS = (
    Q_LORA,
    Q_LORA + KV_LORA,
    Q_LORA + KV_LORA + QK_ROPE,
    Q_LORA + KV_LORA + QK_ROPE + HG_FDIM,
    Q_LORA + KV_LORA + QK_ROPE + 2 * HG_FDIM,
    Q_LORA + KV_LORA + QK_ROPE + 2 * HG_FDIM + HG_VDIM,
)

kernel_name = "hymba_mla_hgrn2_relu2_ple"


def rms_norm(x, g):
    xf = x.astype(jnp.float32)
    y = xf * lax.rsqrt(jnp.mean(xf * xf, axis=-1, keepdims=True) + EPS)
    return (y * g.astype(jnp.float32)).astype(x.dtype)


def rope_tables(positions):
    inv_freq = ROPE_THETA ** (-jnp.arange(0, QK_ROPE, 2, dtype=jnp.float32) / QK_ROPE)
    ang = positions.astype(jnp.float32)[..., None] * inv_freq
    return jnp.cos(ang), jnp.sin(ang)


def apply_rope(t, cos, sin):
    tf = t.astype(jnp.float32)
    t1, t2 = jnp.split(tf, 2, axis=-1)
    return jnp.concatenate([t1 * cos - t2 * sin, t2 * cos + t1 * sin], axis=-1).astype(t.dtype)


def causal_block_attention(q, k, v):
    B, S, H, _ = q.shape
    nb = S // Q_BLOCK
    scale = QK_HEAD ** -0.5
    qb = q.reshape(B, nb, Q_BLOCK, H, QK_HEAD).transpose(1, 0, 2, 3, 4)
    key_pos = jnp.arange(S)

    def one_block(args):
        qi, blk = args
        s = jnp.einsum('bqhd,bkhd->bhqk', qi, k, preferred_element_type=jnp.float32) * scale
        q_pos = blk * Q_BLOCK + jnp.arange(Q_BLOCK)
        s = jnp.where(key_pos[None, :] <= q_pos[:, None], s, -jnp.inf)
        pr = jax.nn.softmax(s, axis=-1).astype(v.dtype)
        return jnp.einsum('bhqk,bkhd->bqhd', pr, v)

    out = lax.map(one_block, (qb, jnp.arange(nb)))
    return out.transpose(1, 0, 2, 3, 4).reshape(B, S, H, V_HEAD)


def hgrn2_chunked(q, k, v, logf):
    B, S, H, dk = q.shape
    dv = v.shape[-1]
    nc = S // CHUNK

    def to_chunks(t):
        return t.reshape(B, nc, CHUNK, H, t.shape[-1]).transpose(1, 0, 3, 2, 4)

    causal = jnp.tril(jnp.ones((CHUNK, CHUNK), dtype=bool))

    def step(state, inp):
        qc, kc, vc, gc = inp
        b = jnp.cumsum(gc, axis=2)
        o_inter = jnp.einsum('bhtk,bhkv->bhtv', qc * jnp.exp(b), state)
        diff = b[:, :, :, None, :] - b[:, :, None, :, :]
        decay = jnp.exp(jnp.where(causal[:, :, None], diff, -jnp.inf))
        a = jnp.einsum('bhtk,bhtsk,bhsk->bhts', qc, decay, kc)
        o = o_inter + jnp.einsum('bhts,bhsv->bhtv', a, vc)
        b_last = b[:, :, -1:, :]
        new_state = jnp.exp(b_last[:, :, 0, :])[..., None] * state + jnp.einsum(
            'bhsk,bhsv->bhkv', kc * jnp.exp(b_last - b), vc)
        return new_state, o

    s0 = jnp.zeros((B, H, dk, dv), jnp.float32)
    _, o = lax.scan(step, s0, (to_chunks(q), to_chunks(k), to_chunks(v), to_chunks(logf)))
    return o.transpose(1, 0, 3, 2, 4).reshape(B, S, H, dv)


def setup_inputs(seed: int = 0) -> dict:
    key = jax.random.key(seed)
    ks = jax.random.split(key, 24)
    f32 = jnp.float32

    def w(k, shape, fan_in):
        return jax.random.normal(k, shape, f32) * (fan_in ** -0.5)

    def gain(k, shape):
        return 1.0 + 0.02 * jax.random.normal(k, shape, f32)

    x = jax.random.normal(ks[0], (BATCH, SEQ, D_MODEL), f32)
    p = jax.random.normal(ks[1], (DEPTH, BATCH, SEQ, PLE_DIM), f32)
    positions = (jax.random.randint(ks[2], (BATCH, 1), 0, 1024, jnp.int32)
                 + jnp.arange(SEQ, dtype=jnp.int32)[None, :])
    return {
        "x": x,
        "p": p,
        "positions": positions,
        "norm_mix": gain(ks[3], (DEPTH, D_MODEL)),
        "w_in": w(ks[4], (DEPTH, D_MODEL, IN_WIDTH), D_MODEL),
        "q_a_norm": gain(ks[5], (DEPTH, Q_LORA)),
        "kv_a_norm": gain(ks[6], (DEPTH, KV_LORA)),
        "w_uq": w(ks[7], (DEPTH, Q_LORA, MLA_HEADS * QK_HEAD), Q_LORA),
        "w_ukv": w(ks[8], (DEPTH, KV_LORA, MLA_HEADS * (QK_NOPE + V_HEAD)), KV_LORA),
        "hg_lower_bound": 0.5 * jax.random.normal(ks[9], (DEPTH + 1, HG_FDIM), f32),
        "hg_out_norm": gain(ks[10], (DEPTH, HG_VDIM)),
        "w_o": w(ks[11], (DEPTH, MIX_WIDTH, D_MODEL), MIX_WIDTH),
        "norm_mlp": gain(ks[12], (DEPTH, D_MODEL)),
        "w_up": w(ks[13], (DEPTH, D_MODEL, D_FF), D_MODEL),
        "w_down": w(ks[14], (DEPTH, D_FF, D_MODEL), D_FF),
        "norm_ple": gain(ks[15], (DEPTH, D_MODEL)),
        "w_ple_gate": w(ks[16], (DEPTH, D_MODEL, D_MODEL), D_MODEL),
        "w_ple": w(ks[17], (DEPTH, PLE_DIM, D_MODEL), PLE_DIM),
        "ple_post_norm": gain(ks[18], (DEPTH, D_MODEL)),
        "final_norm": gain(ks[19], (D_MODEL,)),
    }


def reference(x, p, positions, norm_mix, w_in, q_a_norm, kv_a_norm, w_uq, w_ukv,
              hg_lower_bound, hg_out_norm, w_o, norm_mlp, w_up, w_down,
              norm_ple, w_ple_gate, w_ple, ple_post_norm, final_norm):
    B, S, _ = x.shape
    cos, sin = rope_tables(positions)
    lb_all = jnp.cumsum(jax.nn.softmax(hg_lower_bound.astype(jnp.float32), axis=0), axis=0)
    h = x
    for i in range(DEPTH):
        u = rms_norm(h, norm_mix[i])
        proj = u @ w_in[i]
        c_q, c_kv, k_r, hq, hf, hi, hg = jnp.split(proj, IN_SPLITS, axis=-1)

        q = (rms_norm(c_q, q_a_norm[i]) @ w_uq[i]).reshape(B, S, MLA_HEADS, QK_HEAD)
        q_nope, q_rope = jnp.split(q, [QK_NOPE], axis=-1)
        q = jnp.concatenate([q_nope, apply_rope(q_rope, cos[:, :, None], sin[:, :, None])], axis=-1)
        kv = (rms_norm(c_kv, kv_a_norm[i]) @ w_ukv[i]).reshape(B, S, MLA_HEADS, QK_NOPE + V_HEAD)
        k_nope, v = jnp.split(kv, [QK_NOPE], axis=-1)
        k_rope = apply_rope(k_r, cos, sin)
        k = jnp.concatenate(
            [k_nope, jnp.broadcast_to(k_rope[:, :, None, :], (B, S, MLA_HEADS, QK_ROPE))], axis=-1)
        o_mla = causal_block_attention(q, k, v).reshape(B, S, MLA_HEADS * V_HEAD)

        lb = lb_all[i]
        zf = hf.astype(jnp.float32)
        f = lb + (1.0 - lb) * jax.nn.sigmoid(zf)
        k_h = ((1.0 - lb) * jax.nn.sigmoid(-zf)).reshape(B, S, HG_HEADS, HG_EXPAND)
        logf = jnp.log(f).reshape(B, S, HG_HEADS, HG_EXPAND)
        q_h = jax.nn.silu(hq.astype(jnp.float32)).reshape(B, S, HG_HEADS, HG_EXPAND)
        v_h = hi.astype(jnp.float32).reshape(B, S, HG_HEADS, HG_HEAD_V)
        o_h = hgrn2_chunked(q_h, k_h, logf=logf, v=v_h)
        o_h = rms_norm(o_h, hg_out_norm[i].reshape(HG_HEADS, HG_HEAD_V))
        o_h = o_h * jax.nn.silu(hg.astype(jnp.float32)).reshape(B, S, HG_HEADS, HG_HEAD_V)
        o_h = o_h.reshape(B, S, HG_VDIM).astype(x.dtype)

        h = h + jnp.concatenate([o_mla, o_h], axis=-1) @ w_o[i]

        hidden = jnp.square(jax.nn.relu(rms_norm(h, norm_mlp[i]) @ w_up[i]))
        h = h + hidden @ w_down[i]

        gate = jax.nn.sigmoid(rms_norm(h, norm_ple[i]) @ w_ple_gate[i])
        e = rms_norm(p[i] @ w_ple[i], ple_post_norm[i])
        h = h + gate * e
    return rms_norm(h, final_norm)
```

```cpp
#include <hip/hip_runtime.h>
#include <cstdio>
#include <cstdint>
__device__ __forceinline__ int hw_lane() { int l; asm volatile("v_mbcnt_lo_u32_b32 %0, -1, 0\n\tv_mbcnt_hi_u32_b32 %0, -1, %0" : "=v"(l)); return l; }
namespace pg8 {
#define PG8_LAS __attribute__((address_space(3)))
typedef unsigned short bf16_t;
typedef short bf16x8 __attribute__((ext_vector_type(8)));
typedef float f32x4 __attribute__((ext_vector_type(4)));
typedef unsigned u32x4 __attribute__((ext_vector_type(4)));
typedef int v4i32 __attribute__((ext_vector_type(4)));
typedef int v8i32 __attribute__((ext_vector_type(8)));
constexpr int BM = 256, BK = 64, HALF = 128, HTB = HALF * BK * 2  , STAGE_BYTES = 8 * HTB, NXCD = 8, WGM = 8;

__host__ __device__ __forceinline__ int lds_byte(int r, int c) { const int st = (r >> 4) * 2 + (c >> 5), rr = r & 15, cc = c & 31, ob = rr * 64 + cc * 2; return st * 1024 + (ob ^ (((ob >> 9) & 1) << 5)); }
__host__ __device__ __forceinline__ void stage_rc(int b, int& R, int& C) { const int st = b / 1024, sb = b % 1024, swz = sb ^ (((sb >> 9) & 1) << 5); R = (st >> 1) * 16 + swz / 64; C = (st & 1) * 32 + (swz % 64) / 2; }
__host__ __device__ __forceinline__ int perm32(int rho) { const int n = rho >> 4, i = rho & 15; return 8 * (i >> 2) + 4 * n + (i & 3); }

struct Unit { int pm, pn; };
struct Gemm { const bf16_t* A; const bf16_t* Bt; int M, N, K; };

struct StaticOrder {
    int nM, nN, nwg, G, c;
    __host__ __device__ void init(int M, int N, int G_, int c_) { nM = M / BM; nN = N / BM; nwg = nM * nN; G = G_; c = c_; }
    __host__ __device__ bool next(int i, Unit& u) const {
        const long L = (long)i * G + c; if (L >= nwg) return false;
        int wgid = (int)L; { const int q = nwg / NXCD, r = nwg % NXCD, xcd = wgid % NXCD, off = wgid / NXCD; wgid = (xcd < r ? xcd * (q + 1) : r * (q + 1) + (xcd - r) * q) + off; }
        const int nig = WGM * nN, gid = wgid / nig, fm = gid * WGM, gsz = (nM - fm) < WGM ? (nM - fm) : WGM;
        u.pm = fm + ((wgid % nig) % gsz); u.pn = (wgid % nig) / gsz; return true;
    }
    __device__ __forceinline__ void a_ready(const Unit&) const {}
    __device__ __forceinline__ void done(const Unit&) const {}
};

__device__ __forceinline__ unsigned cvt_pk_bf16(float lo, float hi) { unsigned r; asm volatile("s_nop 0\n\tv_cvt_pk_bf16_f32 %0, %1, %2" : "=v"(r) : "v"(lo), "v"(hi)); return r; }
typedef float f32x2 __attribute__((ext_vector_type(2)));
typedef unsigned u32x2 __attribute__((ext_vector_type(2)));
__device__ __forceinline__ float sigmoidf_(float z) { return __builtin_amdgcn_rcpf(1.0f + __builtin_amdgcn_exp2f(-1.4426950408889634f * z)); }
__device__ __forceinline__ u32x4 pack8(f32x4 a, f32x4 b) { u32x4 w; w.x = cvt_pk_bf16(a[0], a[1]); w.y = cvt_pk_bf16(a[2], a[3]); w.z = cvt_pk_bf16(b[0], b[1]); w.w = cvt_pk_bf16(b[2], b[3]); return w; }

__device__ __forceinline__ void row_sumsq_add(float* accp, float s, int fq) { s += __shfl_xor(s, 16); s += __shfl_xor(s, 32); if (fq == 0) atomicAdd(accp, s); }
__device__ __forceinline__ void row_sumsq_add4(float* base, const float (&q)[4], int fr, int fq) {
    float t[4];
#pragma unroll
    for (int m = 0; m < 4; ++m) { float s = q[m]; s += __shfl_xor(s, 16); s += __shfl_xor(s, 32); t[m] = s; }
    atomicAdd(base + 16 * fq + fr, fq == 0 ? t[0] : fq == 1 ? t[1] : fq == 2 ? t[2] : t[3]);
}
__device__ __forceinline__ float sq4(f32x4 v) { return (v[0] * v[0] + v[1] * v[1]) + (v[2] * v[2] + v[3] * v[3]); }

__device__ __forceinline__ size_t tiled_off(int r, int c, int ldc) { return ((size_t)(r >> 4) * (ldc >> 5) + (c >> 5)) * 512 + (r & 15) * 32 + (c & 31); }
__device__ __forceinline__ size_t tiled_off8(int r, int c, int ldc) { return ((size_t)(r >> 4) * (ldc >> 6) + (c >> 6)) * 1024 + (r & 15) * 64 + (c & 63); }
struct EpiProj {
    static constexpr bool PERM = true, AFTER_DRAIN = false;
    bf16_t* CQ; bf16_t* CKV; float* KRAW; bf16_t* QH; bf16_t* KF; bf16_t* VH; bf16_t* GH; const float* rstd; const float* LB; float* ssq_q; float* ssq_kv;
    __device__ __forceinline__ void operator()(const f32x4 (&acc)[2][2][4][2], const Unit& u, int wr, int wc, int fr, int fq) const {
        const int row0 = u.pm * BM + wr * 64 + fr, t = u.pn, cl = wc * 32 + 8 * fq;
        int cat, cbase;
        if (t < 3) { cat = 0; cbase = t * 256; } else if (t < 5) { cat = 1; cbase = (t - 3) * 256; } else if (t == 5) { cat = 2; cbase = 0; }
        else if (t < 14) { cat = 3; cbase = (t - 6) * 256; } else if (t < 22) { cat = 4; cbase = (t - 14) * 256; } else if (t < 30) { cat = 5; cbase = (t - 22) * 256; } else { cat = 6; cbase = (t - 30) * 256; }
        float rs[2][4];
#pragma unroll
        for (int ai = 0; ai < 2; ++ai)
#pragma unroll
            for (int m = 0; m < 4; ++m) rs[ai][m] = rstd[row0 + ai * HALF + m * 16];
        f32x4 lb[2][2];
#pragma unroll
        for (int bj = 0; bj < 2; ++bj) { lb[bj][0] = (f32x4){0.f, 0.f, 0.f, 0.f}; lb[bj][1] = lb[bj][0]; if (cat == 4) { lb[bj][0] = *(const f32x4*)(LB + cbase + bj * HALF + cl); lb[bj][1] = *(const f32x4*)(LB + cbase + bj * HALF + cl + 4); } }
#pragma unroll
        for (int ai = 0; ai < 2; ++ai) { float qv[4];
#pragma unroll
            for (int m = 0; m < 4; ++m) { const int row = row0 + ai * HALF + m * 16; const float rsv = rs[ai][m]; float qs = 0.f;
#pragma unroll
                for (int bj = 0; bj < 2; ++bj) { const int col = cbase + bj * HALF + cl; f32x4 v0 = acc[ai][bj][m][0] * rsv, v1 = acc[ai][bj][m][1] * rsv;
                    if (cat == 0) { *(u32x4*)(CQ + (size_t)row * 768 + col) = pack8(v0, v1); qs += sq4(v0) + sq4(v1); }
                    else if (cat == 1) { *(u32x4*)(CKV + (size_t)row * 512 + col) = pack8(v0, v1); qs += sq4(v0) + sq4(v1); }
                    else if (cat == 2) { if (bj == 0 && wc < 2) { *(f32x4*)(KRAW + (size_t)row * 64 + col) = v0; *(f32x4*)(KRAW + (size_t)row * 64 + col + 4) = v1; } }
                    else if (cat == 3 || cat == 6) {
#pragma unroll
                        for (int e = 0; e < 4; ++e) { v0[e] = v0[e] * sigmoidf_(v0[e]); v1[e] = v1[e] * sigmoidf_(v1[e]); }
                        *(u32x4*)((cat == 3 ? QH : GH) + (size_t)row * 2048 + col) = pack8(v0, v1); }
                    else if (cat == 4) { const f32x4 l0 = lb[bj][0], l1 = lb[bj][1];
#pragma unroll
                        for (int e = 0; e < 4; ++e) { v0[e] = (1.0f - l0[e]) * sigmoidf_(-v0[e]); v1[e] = (1.0f - l1[e]) * sigmoidf_(-v1[e]); }
                        *(u32x4*)(KF + (size_t)row * 2048 + col) = pack8(v0, v1); }
                    else { *(u32x4*)(VH + (size_t)row * 2048 + col) = pack8(v0, v1); }
                }
                qv[m] = qs; }
            if (cat == 0) row_sumsq_add4(ssq_q + (row0 - fr) + ai * HALF, qv, fr, fq); else if (cat == 1) row_sumsq_add4(ssq_kv + (row0 - fr) + ai * HALF, qv, fr, fq); }
    }
};
struct EpiRowScale {
    static constexpr bool PERM = true, AFTER_DRAIN = false;
    bf16_t* O; int ldc; const float* rs; float scale; float* ssq; float inv_n, eps;
    __device__ __forceinline__ void operator()(const f32x4 (&acc)[2][2][4][2], const Unit& u, int wr, int wc, int fr, int fq) const {
        const int row0 = u.pm * BM + wr * 64 + fr, col0 = u.pn * BM + wc * 32 + 8 * fq;
        float sv[2][4];
#pragma unroll
        for (int ai = 0; ai < 2; ++ai)
#pragma unroll
            for (int m = 0; m < 4; ++m) sv[ai][m] = (rs ? 1.0f / sqrtf(rs[row0 + ai * HALF + m * 16] * inv_n + eps) : 1.0f) * scale;
#pragma unroll
        for (int ai = 0; ai < 2; ++ai) { float qv[4];
#pragma unroll
            for (int m = 0; m < 4; ++m) { const int row = row0 + ai * HALF + m * 16; const float s = sv[ai][m]; float q = 0.f;
#pragma unroll
                for (int bj = 0; bj < 2; ++bj) { const f32x4 v0 = acc[ai][bj][m][0] * s, v1 = acc[ai][bj][m][1] * s; q += sq4(v0) + sq4(v1);
                    *(u32x4*)(O + (size_t)row * ldc + col0 + bj * HALF) = pack8(v0, v1); }
                qv[m] = q; }
            if (ssq) row_sumsq_add4(ssq + (row0 - fr) + ai * HALF, qv, fr, fq); }
    }
};
struct EpiRelu2 {
    static constexpr bool PERM = true, AFTER_DRAIN = false;
    bf16_t* O; int ldc; const float* ssq; float inv_n, eps;
    __device__ __forceinline__ void operator()(const f32x4 (&acc)[2][2][4][2], const Unit& u, int wr, int wc, int fr, int fq) const {
        const int row0 = u.pm * BM + wr * 64 + fr, col0 = u.pn * BM + wc * 32 + 8 * fq;
        float sv[2][4];
#pragma unroll
        for (int ai = 0; ai < 2; ++ai)
#pragma unroll
            for (int m = 0; m < 4; ++m) sv[ai][m] = 1.0f / sqrtf(ssq[row0 + ai * HALF + m * 16] * inv_n + eps);
#pragma unroll
        for (int ai = 0; ai < 2; ++ai)
#pragma unroll
            for (int m = 0; m < 4; ++m) { const int row = row0 + ai * HALF + m * 16; const float s = sv[ai][m];
#pragma unroll
                for (int bj = 0; bj < 2; ++bj) { f32x4 v0 = acc[ai][bj][m][0] * s, v1 = acc[ai][bj][m][1] * s;
#pragma unroll
                    for (int e = 0; e < 4; ++e) { const float a = fmaxf(v0[e], 0.f), b = fmaxf(v1[e], 0.f); v0[e] = a * a; v1[e] = b * b; }
                    *(u32x4*)(O + ((size_t)(row >> 4) * (ldc >> 5) + ((col0 + bj * HALF) >> 5)) * 512 + (row & 15) * 32 + (col0 & 31)) = pack8(v0, v1); } }
    }
};
struct EpiResidX {
    static constexpr bool PERM = true, AFTER_DRAIN = false;
    const float* base; bf16_t* hb; int ldc; float* ssq;
    __device__ __forceinline__ void ldg(f32x4 (&b)[2][2][2], int grp, size_t off0) const {
#pragma unroll
        for (int mm = 0; mm < 2; ++mm)
#pragma unroll
            for (int bj = 0; bj < 2; ++bj)
#pragma unroll
                for (int n = 0; n < 2; ++n) b[mm][bj][n] = *(const f32x4*)(base + off0 + (size_t)((grp >> 1) * HALF + ((grp & 1) * 2 + mm) * 16) * ldc + bj * HALF + n * 4);
    }
    __device__ __forceinline__ void stg(const f32x4 (&b)[2][2][2], const f32x4 (&acc)[2][2][4][2], int grp, size_t off0, int row0, int fq) const {
        const int ai = grp >> 1;
#pragma unroll
        for (int mm = 0; mm < 2; ++mm) { const int m = (grp & 1) * 2 + mm; float q = 0.f;
#pragma unroll
            for (int bj = 0; bj < 2; ++bj) { const size_t o2 = off0 + (size_t)(ai * HALF + m * 16) * ldc + bj * HALF; const f32x4 v0 = b[mm][bj][0] + acc[ai][bj][m][0], v1 = b[mm][bj][1] + acc[ai][bj][m][1]; q += sq4(v0) + sq4(v1);
                *(u32x4*)(hb + o2) = pack8(v0, v1); }
            row_sumsq_add(ssq + row0 + ai * HALF + m * 16, q, fq); }
    }
    __device__ __forceinline__ void operator()(const f32x4 (&acc)[2][2][4][2], const Unit& u, int wr, int wc, int fr, int fq) const {
        const int row0 = u.pm * BM + wr * 64 + fr; const size_t off0 = (size_t)row0 * ldc + u.pn * BM + wc * 32 + 8 * fq;
        f32x4 b0[2][2][2], b1[2][2][2];
        ldg(b0, 0, off0); ldg(b1, 1, off0);
        stg(b0, acc, 0, off0, row0, fq); ldg(b0, 2, off0);
        stg(b1, acc, 1, off0, row0, fq); ldg(b1, 3, off0);
        stg(b0, acc, 2, off0, row0, fq); stg(b1, acc, 3, off0, row0, fq);
    }
};
__device__ __forceinline__ void unpack8(u32x4 w, f32x4& a, f32x4& b) {
    a[0] = __uint_as_float(w.x << 16); a[1] = __uint_as_float(w.x & 0xffff0000u); a[2] = __uint_as_float(w.y << 16); a[3] = __uint_as_float(w.y & 0xffff0000u);
    b[0] = __uint_as_float(w.z << 16); b[1] = __uint_as_float(w.z & 0xffff0000u); b[2] = __uint_as_float(w.w << 16); b[3] = __uint_as_float(w.w & 0xffff0000u);
}
struct EpiResidB {
    static constexpr bool PERM = true, AFTER_DRAIN = false;
    const bf16_t* hin; bf16_t* hout; unsigned char* hf8; int ldc; float* ssq; bool tin, tout;
    __device__ __forceinline__ void operator()(const f32x4 (&acc)[2][2][4][2], const Unit& u, int wr, int wc, int fr, int fq) const {
        const int row0 = u.pm * BM + wr * 64 + fr, col0 = u.pn * BM + wc * 32 + 8 * fq;
        u32x4 b[2][4][2];
#pragma unroll
        for (int ai = 0; ai < 2; ++ai)
#pragma unroll
            for (int m = 0; m < 4; ++m)
#pragma unroll
                for (int bj = 0; bj < 2; ++bj) { const int r = row0 + ai * HALF + m * 16, c = col0 + bj * HALF; b[ai][m][bj] = *(const u32x4*)(hin + (tin ? tiled_off(r, c, ldc) : (size_t)r * ldc + c)); }
#pragma unroll
        for (int ai = 0; ai < 2; ++ai) { float qv[4];
#pragma unroll
            for (int m = 0; m < 4; ++m) { float q = 0.f;
#pragma unroll
                for (int bj = 0; bj < 2; ++bj) { f32x4 x0, x1; unpack8(b[ai][m][bj], x0, x1); x0 = x0 + acc[ai][bj][m][0]; x1 = x1 + acc[ai][bj][m][1]; q += sq4(x0) + sq4(x1);
                    const int r = row0 + ai * HALF + m * 16, c = col0 + bj * HALF;
                    *(u32x4*)(hout + (tout ? tiled_off(r, c, ldc) : (size_t)r * ldc + c)) = pack8(x0, x1);
                    if (hf8) { int w0 = 0, w1 = 0; w0 = __builtin_amdgcn_cvt_pk_fp8_f32(x0[0], x0[1], w0, false); w0 = __builtin_amdgcn_cvt_pk_fp8_f32(x0[2], x0[3], w0, true);
                        w1 = __builtin_amdgcn_cvt_pk_fp8_f32(x1[0], x1[1], w1, false); w1 = __builtin_amdgcn_cvt_pk_fp8_f32(x1[2], x1[3], w1, true);
                        u32x2 w; w.x = (unsigned)w0; w.y = (unsigned)w1; *(u32x2*)(hf8 + tiled_off8(r, c, ldc)) = w; } }
                qv[m] = q; }
            row_sumsq_add4(ssq + (row0 - fr) + ai * HALF, qv, fr, fq); }
    }
};
struct EpiGate {
    static constexpr bool PERM = true, AFTER_DRAIN = false;
    const bf16_t* hin; bf16_t* hout; const bf16_t* E; const float* rs2; const float* rse; const float* gpost; int ldc; float accscale; float inv_n, eps; bf16_t* Gout;
    struct Grp { u32x4 hb[2], eb[2]; float s2, se; };
    __device__ __forceinline__ void ldg(Grp& g, int grp, int row0, size_t off0) const {
        const int r = (grp >> 2) * HALF + (grp & 3) * 16; g.s2 = accscale / sqrtf(rs2[row0 + r] * inv_n + eps); g.se = 1.0f / sqrtf(rse[row0 + r] * inv_n + eps);
#pragma unroll
        for (int bj = 0; bj < 2; ++bj) { const size_t o2 = off0 + (size_t)r * ldc + bj * HALF; g.hb[bj] = *(const u32x4*)(hin + o2); g.eb[bj] = *(const u32x4*)(E + o2); }
    }
    __device__ __forceinline__ void stg(const Grp& g, const f32x4 (&acc)[2][2][4][2], const f32x4 (&gp)[2][2], int grp, size_t off0) const {
        const int ai = grp >> 2, m = grp & 3;
#pragma unroll
        for (int bj = 0; bj < 2; ++bj) { const size_t o2 = off0 + (size_t)(ai * HALF + m * 16) * ldc + bj * HALF; f32x4 h0, h1, e0, e1; unpack8(g.hb[bj], h0, h1); unpack8(g.eb[bj], e0, e1);
            const f32x4 a0 = acc[ai][bj][m][0] * g.s2, a1 = acc[ai][bj][m][1] * g.s2;
            f32x4 s0, s1;
#pragma unroll
            for (int e = 0; e < 4; ++e) { s0[e] = sigmoidf_(a0[e]); s1[e] = sigmoidf_(a1[e]); h0[e] += s0[e] * (e0[e] * g.se * gp[bj][0][e]); h1[e] += s1[e] * (e1[e] * g.se * gp[bj][1][e]); }
            *(u32x4*)(hout + o2) = pack8(h0, h1); *(u32x4*)(Gout + o2) = pack8(s0, s1); }
    }
    __device__ __forceinline__ void operator()(const f32x4 (&acc)[2][2][4][2], const Unit& u, int wr, int wc, int fr, int fq) const {
        const int row0 = u.pm * BM + wr * 64 + fr, col0 = u.pn * BM + wc * 32 + 8 * fq; const size_t off0 = (size_t)row0 * ldc + col0;
        f32x4 gp[2][2];
#pragma unroll
        for (int bj = 0; bj < 2; ++bj)
#pragma unroll
            for (int n = 0; n < 2; ++n) gp[bj][n] = *(const f32x4*)(gpost + col0 + bj * HALF + n * 4);
        Grp g0;
#pragma unroll
        for (int gi = 0; gi < 8; ++gi) { ldg(g0, gi, row0, off0); stg(g0, acc, gp, gi, off0); }
    }
};

struct EpiGateOnly {
    static constexpr bool PERM = true, AFTER_DRAIN = false;
    unsigned char* Gp; const float* ssq2; int ldc; float accscale, inv_n, eps;
    __device__ __forceinline__ void operator()(const f32x4 (&acc)[2][2][4][2], const Unit& u, int wr, int wc, int fr, int fq) const {
        const int row0 = u.pm * BM + wr * 64 + fr, col0 = u.pn * BM + wc * 32 + 8 * fq;
        float sv[2][4];
#pragma unroll
        for (int ai = 0; ai < 2; ++ai)
#pragma unroll
            for (int m = 0; m < 4; ++m) sv[ai][m] = accscale / sqrtf(ssq2[row0 + ai * HALF + m * 16] * inv_n + eps);
#pragma unroll
        for (int ai = 0; ai < 2; ++ai)
#pragma unroll
            for (int m = 0; m < 4; ++m) { const int row = row0 + ai * HALF + m * 16; const float s = sv[ai][m];
#pragma unroll
                for (int bj = 0; bj < 2; ++bj) { f32x4 v0 = acc[ai][bj][m][0] * s, v1 = acc[ai][bj][m][1] * s;
#pragma unroll
                    for (int e = 0; e < 4; ++e) { v0[e] = sigmoidf_(v0[e]) * 255.0f + 0.5f; v1[e] = sigmoidf_(v1[e]) * 255.0f + 0.5f; }
                    u32x2 w; w.x = (unsigned)v0[0] | ((unsigned)v0[1] << 8) | ((unsigned)v0[2] << 16) | ((unsigned)v0[3] << 24); w.y = (unsigned)v1[0] | ((unsigned)v1[1] << 8) | ((unsigned)v1[2] << 16) | ((unsigned)v1[3] << 24);
                    *(u32x2*)(Gp + (size_t)row * ldc + col0 + bj * HALF) = w; } }
    }
};

template <class Epi, class Sched, bool ALIGN_EPI = false, bool SP2 = false, bool FP8 = false, bool ATILED = false>
__device__ __forceinline__ void gemm_phase(PG8_LAS unsigned char* lds, const Gemm g, const Sched& S, const Epi& E, int wid_in) {
    const int wid = __builtin_amdgcn_readfirstlane(wid_in), lane = hw_lane(), tid = wid * 64 + lane, wr = wid >> 2, wc = wid & 3, fr = lane & 15, fq = lane >> 4;
    const int K = g.K, nt = K / BK;
    unsigned voffA[2], voffB[2];
#pragma unroll
    for (int i = 0; i < 2; ++i) { int R, C; stage_rc(tid * 16 + i * 8192, R, C); const int Rb = Epi::PERM ? ((R & ~31) + perm32(R & 31)) : R;
        voffA[i] = ATILED ? (unsigned)((R >> 4) * (K * 32) + (C >> 5) * 1024 + (R & 15) * 64 + (C & 31) * 2) : (unsigned)(R * K + C) * 2u; voffB[i] = (unsigned)(Rb * K + C) * 2u; }
    const size_t kstep = (size_t)(BK * 2);
    const size_t kstepA = ATILED ? (size_t)2048 : kstep;
    const size_t hstep = (size_t)HALF * K * 2;
    const size_t tstep = 2 * hstep;
    const unsigned ldsw = (unsigned)wid * 1024u, ldsbase = (unsigned)(uintptr_t)lds;
    const int aoff = lds_byte(wr * 64 + fr, fq * 8), boff = lds_byte(wc * 32 + fr, fq * 8);
#define PG8_SA(b, h) (((b) * 2 + (h)) * HTB)
#define PG8_SB(b, h) ((4 + (b) * 2 + (h)) * HTB)
#define PG8_STAGE(bufoff, gbase, voff) do { _Pragma("unroll") for (int _i = 0; _i < 2; ++_i) { unsigned keep_; \
        asm volatile("s_mov_b32 %0, m0\n\ts_mov_b32 m0, %1\n\ts_nop 0\n\tglobal_load_lds_dwordx4 %2, %3\n\ts_mov_b32 m0, %0" \
            : "=&s"(keep_) : "s"(ldsbase + (unsigned)((bufoff) + _i * 8192) + ldsw), "v"((voff)[_i]), "s"((const char*)(gbase)) : "memory"); } } while (0)
#define PG8_LDA(dst, b, h) do { _Pragma("unroll") for (int m = 0; m < 4; ++m) _Pragma("unroll") for (int k = 0; k < 2; ++k) dst[m][k] = *(const PG8_LAS bf16x8*)(lds + PG8_SA(b, h) + aoff + m * 2048 + k * 1024); } while (0)
#define PG8_LDB(dst, b, h) do { _Pragma("unroll") for (int n = 0; n < 2; ++n) _Pragma("unroll") for (int k = 0; k < 2; ++k) dst[n][k] = *(const PG8_LAS bf16x8*)(lds + PG8_SB(b, h) + boff + n * 2048 + k * 1024); } while (0)
#define PG8_MMA(ai, bj, At, Bt) do { __builtin_amdgcn_s_setprio(1); \
        if constexpr (FP8) { _Pragma("unroll") for (int m = 0; m < 4; ++m) _Pragma("unroll") for (int n = 0; n < 2; ++n) { \
            const v8i32 fb_ = __builtin_shufflevector(__builtin_bit_cast(v4i32, Bt[n][0]), __builtin_bit_cast(v4i32, Bt[n][1]), 0, 1, 2, 3, 4, 5, 6, 7), fa_ = __builtin_shufflevector(__builtin_bit_cast(v4i32, At[m][0]), __builtin_bit_cast(v4i32, At[m][1]), 0, 1, 2, 3, 4, 5, 6, 7); \
            acc[ai][bj][m][n] = __builtin_amdgcn_mfma_scale_f32_16x16x128_f8f6f4(fb_, fa_, acc[ai][bj][m][n], 0, 0, 0, 0x7f7f7f7f, 0, 0x7f7f7f7f); } } \
        else { _Pragma("unroll") for (int m = 0; m < 4; ++m) _Pragma("unroll") for (int n = 0; n < 2; ++n) _Pragma("unroll") for (int k = 0; k < 2; ++k) \
            acc[ai][bj][m][n] = __builtin_amdgcn_mfma_f32_16x16x32_bf16(Bt[n][k], At[m][k], acc[ai][bj][m][n], 0, 0, 0); } \
        __builtin_amdgcn_s_setprio(0); } while (0)
#define PG8_WAIT_V(n) asm volatile("s_waitcnt vmcnt(" #n ")" ::: "memory")
#define PG8_WAIT_L(n) asm volatile("s_waitcnt lgkmcnt(" #n ")" ::: "memory")
#define PG8_BAR __builtin_amdgcn_s_barrier()
#define PG8_SCHED __builtin_amdgcn_sched_barrier(0)
    Unit cur, nxt; int ui = 0;
    if (!S.next(0, cur)) return;
    f32x4 acc[2][2][4][2];
#pragma unroll
    for (int a = 0; a < 2; ++a)
#pragma unroll
        for (int b = 0; b < 2; ++b)
#pragma unroll
            for (int m = 0; m < 4; ++m)
#pragma unroll
                for (int n = 0; n < 2; ++n) acc[a][b][m][n] = (f32x4){0.f, 0.f, 0.f, 0.f};
    bf16x8 At[4][2], B0[2][2], B1[2][2];
    const char* cA = (const char*)g.A + (size_t)cur.pm * tstep; const char* cB = (const char*)g.Bt + (size_t)cur.pn * tstep;
    S.a_ready(cur);
    if constexpr (SP2) {
        PG8_STAGE(PG8_SB(0, 0), cB, voffB); PG8_STAGE(PG8_SB(0, 1), cB + hstep, voffB); PG8_STAGE(PG8_SA(0, 0), cA, voffA); PG8_STAGE(PG8_SA(0, 1), cA + hstep, voffA);
        if (wr == 1) PG8_BAR;
        PG8_WAIT_V(2); PG8_BAR;
        PG8_STAGE(PG8_SB(1, 0), cB + kstep, voffB); PG8_STAGE(PG8_SA(1, 0), cA + kstepA, voffA); PG8_STAGE(PG8_SB(1, 1), cB + hstep + kstep, voffB);
        PG8_WAIT_V(6); PG8_BAR;
    } else {
        PG8_STAGE(PG8_SB(0, 0), cB, voffB); PG8_STAGE(PG8_SA(0, 0), cA, voffA); PG8_STAGE(PG8_SB(0, 1), cB + hstep, voffB); PG8_STAGE(PG8_SA(0, 1), cA + hstep, voffA);
        if (wr == 1) PG8_BAR;
        PG8_WAIT_V(4); PG8_BAR;
        PG8_STAGE(PG8_SB(1, 0), cB + kstep, voffB); PG8_STAGE(PG8_SA(1, 0), cA + kstepA, voffA); PG8_STAGE(PG8_SB(1, 1), cB + hstep + kstep, voffB);
        PG8_WAIT_V(6); PG8_BAR;
    }
    for (;;) {
        const bool has_next = S.next(ui + 1, nxt);
        const char* nA = has_next ? (const char*)g.A + (size_t)nxt.pm * tstep : cA; const char* nB = has_next ? (const char*)g.Bt + (size_t)nxt.pn * tstep : cB;
        for (int t = 0; t < nt; t += 2) {
            const bool last = (t == nt - 2);
            const char* a1 = cA + (size_t)(t + 1) * kstepA;
            const char* a2 = last ? nA : cA + (size_t)(t + 2) * kstepA; const char* b2 = last ? nB : cB + (size_t)(t + 2) * kstep;
            const char* a3 = a2 + kstepA; const char* b3 = b2 + kstep;
            if (last && has_next) S.a_ready(nxt);
            if constexpr (SP2) {
            PG8_LDB(B0, 0, 0); PG8_LDB(B1, 0, 1); PG8_SCHED; PG8_LDA(At, 0, 0); PG8_STAGE(PG8_SA(1, 1), a1 + hstep, voffA);
            PG8_WAIT_V(8); PG8_WAIT_L(0); PG8_BAR; PG8_MMA(0, 0, At, B0); PG8_MMA(0, 1, At, B1); PG8_BAR; PG8_SCHED;
            PG8_LDA(At, 0, 1); PG8_STAGE(PG8_SB(0, 0), b2, voffB); PG8_STAGE(PG8_SB(0, 1), b2 + hstep, voffB); PG8_STAGE(PG8_SA(0, 0), a2, voffA);
            PG8_WAIT_V(8); PG8_WAIT_L(0); PG8_BAR; PG8_MMA(1, 0, At, B0); PG8_MMA(1, 1, At, B1); PG8_BAR; PG8_SCHED;
            PG8_LDB(B0, 1, 0); PG8_LDB(B1, 1, 1); PG8_SCHED; PG8_LDA(At, 1, 0); PG8_STAGE(PG8_SA(0, 1), a2 + hstep, voffA);
            PG8_WAIT_V(8); PG8_WAIT_L(0); PG8_BAR; PG8_MMA(0, 0, At, B0); PG8_MMA(0, 1, At, B1); PG8_BAR; PG8_SCHED;
            PG8_LDA(At, 1, 1); PG8_STAGE(PG8_SB(1, 0), b3, voffB); PG8_STAGE(PG8_SB(1, 1), b3 + hstep, voffB); PG8_STAGE(PG8_SA(1, 0), a3, voffA);
            PG8_WAIT_V(8); PG8_WAIT_L(0); PG8_BAR; PG8_MMA(1, 0, At, B0); PG8_MMA(1, 1, At, B1); PG8_BAR; PG8_SCHED;
            } else {
            PG8_LDB(B0, 0, 0); PG8_SCHED; PG8_LDA(At, 0, 0); PG8_STAGE(PG8_SA(1, 1), a1 + hstep, voffA);
            PG8_WAIT_L(8); PG8_BAR; PG8_WAIT_L(0); PG8_MMA(0, 0, At, B0); PG8_BAR; PG8_SCHED;
            PG8_LDB(B1, 0, 1); PG8_STAGE(PG8_SB(0, 0), b2, voffB);
            PG8_BAR; PG8_WAIT_L(0); PG8_MMA(0, 1, At, B1); PG8_BAR;
            PG8_LDA(At, 0, 1); PG8_STAGE(PG8_SA(0, 0), a2, voffA);
            PG8_BAR; PG8_WAIT_L(0); PG8_MMA(1, 0, At, B0); PG8_BAR; PG8_SCHED;
            PG8_STAGE(PG8_SB(0, 1), b2 + hstep, voffB);
            PG8_WAIT_V(6); PG8_BAR; PG8_MMA(1, 1, At, B1); PG8_BAR;
            PG8_LDB(B0, 1, 0); PG8_SCHED; PG8_LDA(At, 1, 0); PG8_STAGE(PG8_SA(0, 1), a2 + hstep, voffA);
            PG8_WAIT_L(8); PG8_BAR; PG8_WAIT_L(0); PG8_MMA(0, 0, At, B0); PG8_BAR; PG8_SCHED;
            PG8_LDB(B1, 1, 1); PG8_STAGE(PG8_SB(1, 0), b3, voffB);
            PG8_BAR; PG8_WAIT_L(0); PG8_MMA(0, 1, At, B1); PG8_BAR;
            PG8_LDA(At, 1, 1); PG8_STAGE(PG8_SA(1, 0), a3, voffA);
            PG8_BAR; PG8_WAIT_L(0); PG8_MMA(1, 0, At, B0); PG8_BAR; PG8_SCHED;
            PG8_STAGE(PG8_SB(1, 1), b3 + hstep, voffB);
            PG8_WAIT_V(6); PG8_BAR; PG8_MMA(1, 1, At, B1); PG8_BAR;
            }
        }
        if constexpr (ALIGN_EPI) { if (wr == 0) PG8_BAR; }
        if constexpr (!Epi::AFTER_DRAIN) { const int le_ = hw_lane(); E(acc, cur, wr, wc, le_ & 15, le_ >> 4); S.done(cur); }
        if (!has_next) break;
#pragma unroll
        for (int a = 0; a < 2; ++a)
#pragma unroll
            for (int b = 0; b < 2; ++b)
#pragma unroll
                for (int m = 0; m < 4; ++m)
#pragma unroll
                    for (int n = 0; n < 2; ++n) acc[a][b][m][n] = (f32x4){0.f, 0.f, 0.f, 0.f};
        cur = nxt; cA = nA; cB = nB; ++ui;
        if constexpr (ALIGN_EPI) { if (wr == 1) PG8_BAR; }
    }
    PG8_WAIT_V(0);
    if constexpr (!ALIGN_EPI) { if (wr == 0) PG8_BAR; }
    PG8_BAR;
    if constexpr (Epi::AFTER_DRAIN) { E.fused(acc, cur, wr, wc, fr, fq, lds, wid, lane); S.done(cur); }
#undef PG8_SA
#undef PG8_SB
#undef PG8_STAGE
#undef PG8_LDA
#undef PG8_LDB
#undef PG8_MMA
#undef PG8_WAIT_V
#undef PG8_WAIT_L
#undef PG8_BAR
#undef PG8_SCHED
}
}
namespace att {
#define ALAS __attribute__((address_space(3)))
typedef unsigned short bf16_t;
typedef short bf16x8 __attribute__((ext_vector_type(8)));
typedef short s16x4 __attribute__((ext_vector_type(4)));
typedef float f32x16 __attribute__((ext_vector_type(16)));
typedef float f32x4 __attribute__((ext_vector_type(4)));
typedef unsigned u32x4 __attribute__((ext_vector_type(4)));
constexpr int SEQ = 4096, NH = 16, QKD = 192, VD = 128, QPITCH = NH * QKD  , KVPITCH = NH * 256  , OPITCH = 4096;
constexpr int SHM_V = 64 * 256, SHM_K = 64 * 384;
constexpr int OFF_V = 0, OFF_K = 3 * SHM_V, OFF_WS = 3 * SHM_V + 3 * SHM_K, LDS_BYTES = OFF_WS + 8 * 64 * 4;
#define KSWZ(row, colB) ((row) * 384 + ((colB) ^ ((((row) >> 1) & 7) << 4)))
#define SBAR() __builtin_amdgcn_sched_barrier(0)
__device__ __forceinline__ int v_st(int k, int c) { const int kk = (k & ~0xC) | ((k & 4) << 1) | ((k & 8) >> 1); return ((kk >> 3) * 4 + (c >> 5)) * 512 + ((kk & 7) * 32 + (c & 31)) * 2; }
__device__ __forceinline__ int v_rd_base(int lane) { return ((lane & 3) << 3) | (((lane >> 2) & 3) << 6) | (((lane >> 4) & 1) << 5) | (((lane >> 5) & 1) << 8); }
constexpr int v_rd_off(int d0, int ks, int half) { return d0 * 512 + ks * 4096 + half * 2048; }
__device__ __forceinline__ int crow(int r, int hi) { return (r & 3) + 8 * (r >> 2) + 4 * hi; }
__device__ __forceinline__ unsigned cvtpk(float lo, float hi) { unsigned r; asm volatile("s_nop 0\n\tv_cvt_pk_bf16_f32 %0, %1, %2" : "=v"(r) : "v"(lo), "v"(hi)); return r; }
__device__ __forceinline__ float bflo(unsigned w) { return __uint_as_float(w << 16); }
__device__ __forceinline__ float bfhi(unsigned w) { return __uint_as_float(w & 0xffff0000u); }

__device__ __forceinline__ void qkt(f32x16& p0, f32x16& p1, ALAS const char* Kt, int r32, int hi, const bf16x8* qr) {
    p0 = f32x16{}; p1 = f32x16{};
    ALAS const char* kb[4];
#pragma unroll
    for (int dd = 0; dd < 4; ++dd) kb[dd] = Kt + KSWZ(r32, (dd * 16 + hi * 8) * 2);
    bf16x8 kf[2][4];
#define KLD(bi_, sl_) do { _Pragma("unroll") for (int e_ = 0; e_ < 2; ++e_) { const int d0_ = 2 * (bi_) + e_; ALAS const char* a_ = kb[d0_ & 3] + (d0_ >> 2) * 128; \
        kf[sl_][2 * e_] = *(ALAS const bf16x8*)a_; kf[sl_][2 * e_ + 1] = *(ALAS const bf16x8*)(a_ + 32 * 384); } } while (0)
    KLD(0, 0);
#pragma unroll
    for (int bi = 0; bi < 6; ++bi) {
        if (bi < 5) KLD(bi + 1, (bi + 1) & 1);
        SBAR(); __builtin_amdgcn_s_setprio(1);
#pragma unroll
        for (int e = 0; e < 2; ++e) { const int d0 = 2 * bi + e;
            p0 = __builtin_amdgcn_mfma_f32_32x32x16_bf16(kf[bi & 1][2 * e], qr[d0], p0, 0, 0, 0);
            p1 = __builtin_amdgcn_mfma_f32_32x32x16_bf16(kf[bi & 1][2 * e + 1], qr[d0], p1, 0, 0, 0); }
        __builtin_amdgcn_s_setprio(0); SBAR();
    }
#undef KLD
}
__device__ __forceinline__ void pv_tile(f32x16* o, int vb, bf16x8 pa0, bf16x8 pa1, bf16x8 pa2, bf16x8 pa3) {
#define TRRD(dst, off) asm volatile("ds_read_b64_tr_b16 %0, %1 offset:%2" : "=&v"(dst) : "v"(vb), "i"(off) : "memory")
#define PV_D0(d0) do { s16x4 l0, l1, l2, l3, h0, h1, h2, h3; constexpr int b_ = v_rd_off(d0, 0, 0); \
        TRRD(l0, b_); TRRD(h0, b_ + 2048); TRRD(l1, b_ + 4096); TRRD(h1, b_ + 6144); TRRD(l2, b_ + 8192); TRRD(h2, b_ + 10240); TRRD(l3, b_ + 12288); TRRD(h3, b_ + 14336); \
        asm volatile("s_waitcnt lgkmcnt(0)" ::: "memory"); SBAR(); __builtin_amdgcn_s_setprio(1); \
        o[d0] = __builtin_amdgcn_mfma_f32_32x32x16_bf16(pa0, (bf16x8){l0[0], l0[1], l0[2], l0[3], h0[0], h0[1], h0[2], h0[3]}, o[d0], 0, 0, 0); \
        o[d0] = __builtin_amdgcn_mfma_f32_32x32x16_bf16(pa1, (bf16x8){l1[0], l1[1], l1[2], l1[3], h1[0], h1[1], h1[2], h1[3]}, o[d0], 0, 0, 0); \
        o[d0] = __builtin_amdgcn_mfma_f32_32x32x16_bf16(pa2, (bf16x8){l2[0], l2[1], l2[2], l2[3], h2[0], h2[1], h2[2], h2[3]}, o[d0], 0, 0, 0); \
        o[d0] = __builtin_amdgcn_mfma_f32_32x32x16_bf16(pa3, (bf16x8){l3[0], l3[1], l3[2], l3[3], h3[0], h3[1], h3[2], h3[3]}, o[d0], 0, 0, 0); __builtin_amdgcn_s_setprio(0); } while (0)
    PV_D0(0); PV_D0(1); PV_D0(2); PV_D0(3);
#undef PV_D0
#undef TRRD
}
struct Tensors { const bf16_t* Q; const bf16_t* KV; const bf16_t* KR; const float* RC; const float* RS; bf16_t* O; };
__device__ __forceinline__ void unit(const Tensors& T, int bh, int qb, ALAS char* lds, int wid_in) {
    const int wid = __builtin_amdgcn_readfirstlane(wid_in), lane = hw_lane(), tid = wid * 64 + lane, r32 = lane & 31, hi = lane >> 5;
    const int b = bh >> 4, h = bh & 15; const size_t rowbase = (size_t)b * SEQ; const int q0 = qb * 256, NT = 4 * (qb + 1);
    ALAS char* V_lds = lds + OFF_V; ALAS char* K_lds = lds + OFF_K;
    ALAS float* ws = (ALAS float*)(lds + OFF_WS) + wid * 64; ALAS float* li_l = ws; ALAS float* al_l = ws + 32;
    const size_t qrow = rowbase + q0 + wid * 32 + r32;
    const bf16_t* Qw = T.Q + qrow * QPITCH + h * QKD + hi * 8;
    bf16x8 qr[12];
#pragma unroll
    for (int d0 = 0; d0 < 12; ++d0) qr[d0] = *(const bf16x8*)(Qw + d0 * 16);
#pragma unroll
    for (int p = 0; p < 2; ++p) { const float* cp = T.RC + qrow * 32 + 16 * p + 8 * hi; const float* sp = T.RS + qrow * 32 + 16 * p + 8 * hi;
        const f32x4 c0 = *(const f32x4*)cp, c1 = *(const f32x4*)(cp + 4), s0 = *(const f32x4*)sp, s1 = *(const f32x4*)(sp + 4);
        const u32x4 a = __builtin_bit_cast(u32x4, qr[8 + p]), bb = __builtin_bit_cast(u32x4, qr[10 + p]); u32x4 na, nb;
#pragma unroll
        for (int w = 0; w < 4; ++w) { const float cl = w < 2 ? c0[2 * w] : c1[2 * w - 4], ch = w < 2 ? c0[2 * w + 1] : c1[2 * w - 3], sl = w < 2 ? s0[2 * w] : s1[2 * w - 4], sh = w < 2 ? s0[2 * w + 1] : s1[2 * w - 3];
            const float x1l = bflo(a[w]), x1h = bfhi(a[w]), x2l = bflo(bb[w]), x2h = bfhi(bb[w]);
            na[w] = cvtpk(x1l * cl - x2l * sl, x1h * ch - x2h * sh); nb[w] = cvtpk(x2l * cl + x1l * sl, x2h * ch + x1h * sh); }
        qr[8 + p] = __builtin_bit_cast(bf16x8, na); qr[10 + p] = __builtin_bit_cast(bf16x8, nb); }
    const char* KVb = (const char*)T.KV; const char* KRb = (const char*)T.KR;
    unsigned koff[3]; unsigned krope = 0u;
#pragma unroll
    for (int i = 0; i < 3; ++i) { const int ci = (wid + 8 * i) * 64 + lane, row = ci / 24, sl = ci - row * 24, c = ((sl & 7) ^ ((row >> 1) & 7)) | (sl & 24);
        const bool rp = c >= 16; if (rp) krope |= (1u << i);
        koff[i] = rp ? (unsigned)(((rowbase + row) * 64 + (c - 16) * 8) * 2) : (unsigned)(((rowbase + row) * KVPITCH + h * 256 + c * 8) * 2); }
    unsigned voff[2];
#pragma unroll
    for (int i = 0; i < 2; ++i) { const int ob = (wid + 8 * i) * 1024 + lane * 16, st = ob >> 9, kk = (st >> 2) * 8 + ((ob & 511) >> 6), c = (st & 3) * 32 + ((ob & 63) >> 1), k = (kk & ~0xC) | ((kk & 4) << 1) | ((kk & 8) >> 1);
        voff[i] = (unsigned)(((rowbase + k) * KVPITCH + h * 256 + 128 + c) * 2); }
    const int vb0 = (int)(unsigned)(uintptr_t)V_lds + v_rd_base(lane);
#define SDMA(t_, ko_, vo_) do { \
        _Pragma("unroll") for (int i_ = 0; i_ < 3; ++i_) { const bool rp_ = (krope >> i_) & 1u; const char* src_ = (rp_ ? KRb : KVb) + (koff[i_] + (unsigned)(t_) * (rp_ ? 8192u : 64u * KVPITCH * 2u)); \
            __builtin_amdgcn_global_load_lds((const unsigned*)src_, (ALAS unsigned*)(K_lds + (ko_) + (wid + 8 * i_) * 1024), 16, 0, 0); } \
        _Pragma("unroll") for (int i_ = 0; i_ < 2; ++i_) { const char* src_ = KVb + (voff[i_] + (unsigned)(t_) * (64u * KVPITCH * 2u)); \
            __builtin_amdgcn_global_load_lds((const unsigned*)src_, (ALAS unsigned*)(V_lds + (vo_) + (wid + 8 * i_) * 1024), 16, 0, 0); } } while (0)
    float m_reg = -1e30f, l_reg = 0.f; f32x16 o[4] = {};
    const int qlo = q0 + wid * 32, qpos = qlo + r32;
    SDMA(0, 0, 0); SDMA(1, SHM_K, SHM_V);
    asm volatile("s_waitcnt vmcnt(5)" ::: "memory"); __builtin_amdgcn_s_barrier(); asm volatile("" ::: "memory");
    f32x16 p0, p1; bf16x8 pa0, pa1, pa2, pa3;
#define PK4(P, B_, OUT) do { unsigned a0 = cvtpk(P[B_ + 0], P[B_ + 1]), a1 = cvtpk(P[B_ + 2], P[B_ + 3]); unsigned b0 = cvtpk(P[B_ + 4], P[B_ + 5]), b1 = cvtpk(P[B_ + 6], P[B_ + 7]); \
        auto r0 = __builtin_amdgcn_permlane32_swap(a0, b0, false, false); auto r1 = __builtin_amdgcn_permlane32_swap(a1, b1, false, false); \
        u32x4 w = {r0[0], r1[0], r0[1], r1[1]}; OUT = __builtin_bit_cast(bf16x8, w); } while (0)
#define QK_SM(tt_, ko_) do { SBAR(); qkt(p0, p1, K_lds + (ko_), r32, hi, qr); \
        { const int kb_ = (tt_) * 64; if (kb_ + 63 > qlo) { const int dq = qpos - kb_ - 4 * hi; const float NEG = -__builtin_inff(); \
            _Pragma("unroll") for (int r = 0; r < 16; ++r) { const int c = (r & 3) + 8 * (r >> 2); if (c > dq) p0[r] = NEG; if (c + 32 > dq) p1[r] = NEG; } } } \
        float pmax = p0[0]; _Pragma("unroll") for (int r = 1; r < 16; ++r) pmax = fmaxf(pmax, p0[r]); _Pragma("unroll") for (int r = 0; r < 16; ++r) pmax = fmaxf(pmax, p1[r]); \
        { auto rr_ = __builtin_amdgcn_permlane32_swap(__float_as_uint(pmax), __float_as_uint(pmax), false, false); pmax = fmaxf(__uint_as_float(rr_[0]), __uint_as_float(rr_[1])); } \
        float alpha = 1.f; \
        if (!__all(pmax - m_reg <= 8.0f)) { const float mn = fmaxf(m_reg, pmax); alpha = __builtin_amdgcn_exp2f(m_reg - mn); m_reg = mn;     \
            if (hi == 0) al_l[r32] = alpha; asm volatile("s_waitcnt lgkmcnt(0)" ::: "memory"); \
            _Pragma("unroll") for (int d_ = 0; d_ < 4; ++d_) _Pragma("unroll") for (int r = 0; r < 16; ++r) o[d_][r] *= al_l[crow(r, hi)]; } \
        _Pragma("unroll") for (int r = 0; r < 16; ++r) { p0[r] = __builtin_amdgcn_exp2f(p0[r] - m_reg); p1[r] = __builtin_amdgcn_exp2f(p1[r] - m_reg); } \
        float ps = 0.f; _Pragma("unroll") for (int r = 0; r < 16; ++r) ps += p0[r]; _Pragma("unroll") for (int r = 0; r < 16; ++r) ps += p1[r]; \
        { auto rr_ = __builtin_amdgcn_permlane32_swap(__float_as_uint(ps), __float_as_uint(ps), false, false); ps = __uint_as_float(rr_[0]) + __uint_as_float(rr_[1]); } \
        l_reg = l_reg * alpha + ps; \
        PK4(p0, 0, pa0); PK4(p0, 8, pa1); PK4(p1, 0, pa2); PK4(p1, 8, pa3); SBAR(); } while (0)
    int ko = 0, vo = 0, kn2 = 2 * SHM_K, vn2 = 2 * SHM_V;
    for (int t = 0; t < NT; ++t) { const bool more2 = t + 2 < NT;
        if (more2) SDMA(t + 2, kn2, vn2);
        if (t * 64 <= qlo + 31) {
            QK_SM(t, ko);
            pv_tile(o, vb0 + vo, pa0, pa1, pa2, pa3); }
        asm volatile("s_waitcnt lgkmcnt(0)" ::: "memory");
        if (more2) asm volatile("s_waitcnt vmcnt(5)" ::: "memory"); else asm volatile("s_waitcnt vmcnt(0)" ::: "memory");
        __builtin_amdgcn_s_barrier(); asm volatile("" ::: "memory");
        kn2 = ko; vn2 = vo;
        ko = (ko == 2 * SHM_K) ? 0 : ko + SHM_K; vo = (vo == 2 * SHM_V) ? 0 : vo + SHM_V; }
#undef PK4
#undef QK_SM
#undef SDMA
    if (hi == 0) li_l[r32] = l_reg; asm volatile("s_waitcnt lgkmcnt(0)" ::: "memory");
    float rli[16];
#pragma unroll
    for (int r = 0; r < 16; ++r) rli[r] = __builtin_amdgcn_rcpf(li_l[crow(r, hi)]);
    bf16_t* Ow = T.O + (rowbase + q0 + wid * 32) * OPITCH + h * VD;
    ALAS char* stg = K_lds + wid * (32 * 272);
#pragma unroll
    for (int r = 0; r < 16; ++r) { const int orow = crow(r, hi);
#pragma unroll
        for (int d0 = 0; d0 < 4; ++d0) { const float v = o[d0][r] * rli[r]; const float vn = __int_as_float(__builtin_amdgcn_mov_dpp(__float_as_int(v), 0xB1  , 0xF, 0xF, true));
            if ((r32 & 1) == 0) *(ALAS unsigned*)(stg + orow * 272 + (d0 * 32 + r32) * 2) = cvtpk(v, vn); } }
    asm volatile("s_waitcnt lgkmcnt(0)" ::: "memory");
#pragma unroll
    for (int j = 0; j < 8; ++j) { const int idx = j * 64 + lane, row = idx >> 4, ch = idx & 15; const u32x4 w = *(ALAS const u32x4*)(stg + row * 272 + ch * 16);
        *(u32x4*)(Ow + (size_t)row * OPITCH + ch * 8) = w; }
    __syncthreads();
}
#undef SBAR
}
namespace hg {
#define HLAS __attribute__((address_space(3)))
#define HGAS __attribute__((address_space(1)))
#define HG_SYNC() do { asm volatile("s_waitcnt lgkmcnt(0)" ::: "memory"); __builtin_amdgcn_s_barrier(); asm volatile("" ::: "memory"); } while (0)
typedef unsigned short bf16_t;
typedef short bf16x8 __attribute__((ext_vector_type(8)));
typedef short s16x4 __attribute__((ext_vector_type(4)));
typedef float f32x16 __attribute__((ext_vector_type(16)));
typedef float f32x4 __attribute__((ext_vector_type(4)));
typedef unsigned u32x4 __attribute__((ext_vector_type(4)));
typedef unsigned u32x2 __attribute__((ext_vector_type(2)));
constexpr int SEQ = 4096, HGD = 2048, NCH = 64  , NUNIT = 4 * 16 * NCH;
__device__ __forceinline__ unsigned cvtpk(float lo, float hi) { unsigned r; asm volatile("s_nop 0\n\tv_cvt_pk_bf16_f32 %0, %1, %2" : "=v"(r) : "v"(lo), "v"(hi)); return r; }
__device__ __forceinline__ float bflo(unsigned w) { return __uint_as_float(w << 16); }
__device__ __forceinline__ float bfhi(unsigned w) { return __uint_as_float(w & 0xffff0000u); }

constexpr int P1_V = 0, P1_K = 16384, P1_GT = 32768;
struct P1In { u32x2 kw[4]; u32x4 v0, v1; };
__device__ __forceinline__ void pass1_load(P1In& I, const bf16_t* KF, const bf16_t* VH, int unit, int tid) {
    const int bh = unit >> 6, c = unit & 63, b = bh >> 4, h = bh & 15; const size_t row0 = (size_t)b * SEQ + 64 * c;
    const int cq = tid & 31, tg = tid >> 5;
#pragma unroll
    for (int i = 0; i < 4; ++i) I.kw[i] = *(const HGAS u32x2*)(KF + (row0 + 4 * tg + i) * HGD + h * 128 + 4 * cq);
    const int sr = tid >> 4, sc = tid & 15; const bf16_t* vp = VH + (row0 + sr) * HGD + h * 128 + sc * 8;
    I.v0 = *(const HGAS u32x4*)vp; I.v1 = *(const HGAS u32x4*)(vp + 32 * HGD);
}
__device__ __forceinline__ void pass1_compute(const P1In& I, bf16_t* UT, float* DD, int unit, HLAS char* lds, int wid, int lane) {
    const int tid = wid * 64 + lane;
    const int cq = tid & 31, tg = tid >> 5;
    f32x4 f[4];
#pragma unroll
    for (int i = 0; i < 4; ++i) f[i] = (f32x4){1.f - bflo(I.kw[i].x), 1.f - bfhi(I.kw[i].x), 1.f - bflo(I.kw[i].y), 1.f - bfhi(I.kw[i].y)};
    { const int sr = tid >> 4, sc = tid & 15;
      *(HLAS u32x4*)(lds + P1_V + att::v_st(sr, sc * 8)) = I.v0; *(HLAS u32x4*)(lds + P1_V + att::v_st(32 + sr, sc * 8)) = I.v1; }
    f32x4 suf[4]; suf[3] = (f32x4){1.f, 1.f, 1.f, 1.f}; suf[2] = f[3]; suf[1] = f[3] * f[2]; suf[0] = suf[1] * f[1];
    const f32x4 gt = suf[0] * f[0];
    HLAS f32x4* GT = (HLAS f32x4*)(lds + P1_GT);
    GT[tg * 32 + cq] = gt;
    HG_SYNC();
    f32x4 lp = (f32x4){1.f, 1.f, 1.f, 1.f};
#pragma unroll
    for (int i = 1; i < 16; ++i) { const f32x4 g = GT[i * 32 + cq]; if (i > tg) lp = lp * g; }
    if (tg == 0) *(HGAS f32x4*)(DD + (size_t)unit * 128 + 4 * cq) = lp * gt;
#pragma unroll
    for (int i = 0; i < 4; ++i) { const f32x4 kt = ((f32x4){1.f, 1.f, 1.f, 1.f} - f[i]) * suf[i] * lp;
        u32x2 w; w.x = cvtpk(kt.x, kt.y); w.y = cvtpk(kt.z, kt.w); *(HLAS u32x2*)(lds + P1_K + att::v_st(4 * tg + i, 4 * cq)) = w; }
    HG_SYNC();
    const int vt = wid >> 1, kt0 = 2 * (wid & 1);
    const int vbV = (int)(unsigned)(uintptr_t)(lds + P1_V) + att::v_rd_base(lane), vbK = (int)(unsigned)(uintptr_t)(lds + P1_K) + att::v_rd_base(lane);
    f32x16 acc0 = {}, acc1 = {};
#define HTR(dst, base, off) asm volatile("ds_read_b64_tr_b16 %0, %1 offset:%2" : "=&v"(dst) : "v"(base), "i"(off) : "memory")
#pragma unroll
    for (int ks = 0; ks < 4; ++ks) { s16x4 al, ah, b0l, b0h, b1l, b1h;
        const int oa = vt * 512 + ks * 4096, ob = kt0 * 512 + ks * 4096;
        asm volatile("ds_read_b64_tr_b16 %0, %1" : "=&v"(al) : "v"(vbV + oa) : "memory"); asm volatile("ds_read_b64_tr_b16 %0, %1" : "=&v"(ah) : "v"(vbV + oa + 2048) : "memory");
        asm volatile("ds_read_b64_tr_b16 %0, %1" : "=&v"(b0l) : "v"(vbK + ob) : "memory"); asm volatile("ds_read_b64_tr_b16 %0, %1" : "=&v"(b0h) : "v"(vbK + ob + 2048) : "memory");
        asm volatile("ds_read_b64_tr_b16 %0, %1" : "=&v"(b1l) : "v"(vbK + ob + 512) : "memory"); asm volatile("ds_read_b64_tr_b16 %0, %1" : "=&v"(b1h) : "v"(vbK + ob + 512 + 2048) : "memory");
        asm volatile("s_waitcnt lgkmcnt(0)" ::: "memory"); __builtin_amdgcn_sched_barrier(0);
        const bf16x8 a = {al[0], al[1], al[2], al[3], ah[0], ah[1], ah[2], ah[3]}, b0 = {b0l[0], b0l[1], b0l[2], b0l[3], b0h[0], b0h[1], b0h[2], b0h[3]}, b1 = {b1l[0], b1l[1], b1l[2], b1l[3], b1h[0], b1h[1], b1h[2], b1h[3]};
        acc0 = __builtin_amdgcn_mfma_f32_32x32x16_bf16(a, b0, acc0, 0, 0, 0); acc1 = __builtin_amdgcn_mfma_f32_32x32x16_bf16(a, b1, acc1, 0, 0, 0); }
#undef HTR
    { const int r32 = lane & 31, hi = lane >> 5; HLAS char* stg = lds + 40960 + wid * (32 * 144);
#pragma unroll
      for (int r = 0; r < 16; ++r) { const int vrow = att::crow(r, hi); const float a0 = acc0[r], a1 = acc1[r];
          const float n0 = __int_as_float(__builtin_amdgcn_mov_dpp(__float_as_int(a0), 0xB1, 0xF, 0xF, true)), n1 = __int_as_float(__builtin_amdgcn_mov_dpp(__float_as_int(a1), 0xB1, 0xF, 0xF, true));
          if ((r32 & 1) == 0) { *(HLAS unsigned*)(stg + vrow * 144 + r32 * 2) = cvtpk(a0, n0); *(HLAS unsigned*)(stg + vrow * 144 + (32 + r32) * 2) = cvtpk(a1, n1); } }
      asm volatile("s_waitcnt lgkmcnt(0)" ::: "memory");
      bf16_t* up = UT + (size_t)unit * 16384 + (size_t)(32 * vt) * 128 + 32 * kt0;
#pragma unroll
      for (int j = 0; j < 4; ++j) { const int idx = j * 64 + lane, row = idx >> 3, ch = idx & 7; const u32x4 w = *(HLAS const u32x4*)(stg + row * 144 + ch * 16);
          *(HGAS u32x4*)(up + (size_t)row * 128 + ch * 8) = w; } }
    HG_SYNC();
}
__device__ __forceinline__ void pass1_all(const bf16_t* KF, const bf16_t* VH, bf16_t* UT, float* DD, int u0, int ustride, HLAS char* lds, int wid_in) {
    const int wid = __builtin_amdgcn_readfirstlane(wid_in), lane = hw_lane(), tid = wid * 64 + lane;
    P1In A, B;
    int u = u0;
    if (u < NUNIT) pass1_load(A, KF, VH, u, tid);
    while (u < NUNIT) {
        const int u2 = u + ustride, u3 = u2 + ustride;
        if (u2 < NUNIT) pass1_load(B, KF, VH, u2, tid);
        pass1_compute(A, UT, DD, u, lds, wid, lane);
        if (u2 >= NUNIT) break;
        if (u3 < NUNIT) pass1_load(A, KF, VH, u3, tid);
        pass1_compute(B, UT, DD, u2, lds, wid, lane);
        u = u3;
    }
}

__device__ __forceinline__ void pass2_scan(bf16_t* UT, const float* DD, int gt, int NGT) {
    for (int idx = gt; idx < 64 * 2048; idx += NGT) {
        const int bh = idx >> 11, rem = idx & 2047, v = rem >> 4, ko = rem & 15;
        bf16_t* up = UT + (size_t)bh * NCH * 16384 + (size_t)v * 128 + 8 * ko; const float* dp = DD + (size_t)bh * NCH * 128 + 8 * ko;
        float S[8] = {0.f, 0.f, 0.f, 0.f, 0.f, 0.f, 0.f, 0.f};
        for (int c0 = 0; c0 < NCH; c0 += 8) {
            u32x4 u[8]; f32x4 d0[8], d1[8];
#pragma unroll
            for (int i = 0; i < 8; ++i) { u[i] = *(const HGAS u32x4*)(up + (size_t)(c0 + i) * 16384); d0[i] = *(const HGAS f32x4*)(dp + (size_t)(c0 + i) * 128); d1[i] = *(const HGAS f32x4*)(dp + (size_t)(c0 + i) * 128 + 4); }
#pragma unroll
            for (int i = 0; i < 8; ++i) {
                u32x4 o; o.x = cvtpk(S[0], S[1]); o.y = cvtpk(S[2], S[3]); o.z = cvtpk(S[4], S[5]); o.w = cvtpk(S[6], S[7]);
                *(HGAS u32x4*)(up + (size_t)(c0 + i) * 16384) = o;
                S[0] = d0[i].x * S[0] + bflo(u[i].x); S[1] = d0[i].y * S[1] + bfhi(u[i].x); S[2] = d0[i].z * S[2] + bflo(u[i].y); S[3] = d0[i].w * S[3] + bfhi(u[i].y);
                S[4] = d1[i].x * S[4] + bflo(u[i].z); S[5] = d1[i].y * S[5] + bfhi(u[i].z); S[6] = d1[i].z * S[6] + bflo(u[i].w); S[7] = d1[i].w * S[7] + bfhi(u[i].w); }
        }
    }
}

constexpr int RSQ = 272, RSV = 288;
constexpr int P3_QH = 0, P3_QT = 64 * RSQ, P3_W = 128 * RSQ, P3_V = 288 * RSQ, P3_GT = P3_V + 64 * RSV, P3_SS = P3_GT + 8192, P3_END = P3_SS + 512;
static_assert(P3_END <= 131072, "pass-3 LDS");
constexpr int P3_S0 = P3_END, P3_S1 = 131072 + 1024;
static_assert(P3_S0 + 16384 <= 131072, "pass-3 state stage");
__device__ __forceinline__ void pass3_sdma(const bf16_t* ST, int unit, HLAS char* lds, int wid, int lane) {
    const char* sb = (const char*)ST + (size_t)unit * 32768;
#pragma unroll
    for (int i = 0; i < 4; ++i) { const int p = wid + 8 * i, r = 4 * p + (lane >> 4), c = (lane & 15) ^ (r & 15);
        __builtin_amdgcn_global_load_lds((const unsigned*)(sb + r * 256 + c * 16), (HLAS unsigned*)(lds + (i < 2 ? P3_S0 + 1024 * p : P3_S1 + 1024 * (p - 16))), 16, 0, 0); }
    __builtin_amdgcn_sched_barrier(0);
}
__device__ __forceinline__ int wbase(int J) { return J == 0 ? 0 : J == 1 ? 16 : J == 2 ? 48 : 96; }
struct P3In { u32x2 kw[4]; u32x2 qw[4]; u32x4 v0, v1; };
__device__ __forceinline__ void pass3_load(P3In& I, const bf16_t* KF, const bf16_t* QH, const bf16_t* VH, int unit, int tid) {
    const int bh = unit >> 6, c = unit & 63, b = bh >> 4, h = bh & 15; const size_t row0 = (size_t)b * SEQ + 64 * c;
    const int cq = tid & 31, tg = tid >> 5;
#pragma unroll
    for (int i = 0; i < 4; ++i) { I.kw[i] = *(const HGAS u32x2*)(KF + (row0 + 4 * tg + i) * HGD + h * 128 + 4 * cq); I.qw[i] = *(const HGAS u32x2*)(QH + (row0 + 4 * tg + i) * HGD + h * 128 + 4 * cq); }
    const int sr = tid >> 4, sc = tid & 15; const bf16_t* vp = VH + (row0 + sr) * HGD + h * 128 + sc * 8;
    I.v0 = *(const HGAS u32x4*)vp; I.v1 = *(const HGAS u32x4*)(vp + 32 * HGD);
}
__device__ __forceinline__ void pass3_compute(const P3In& I, const bf16_t* GH, const bf16_t* ST, const float* gout, bf16_t* MIX, int unit, int next_unit  , bool prefetched  , HLAS char* lds, int wid, int lane) {
    const int tid = wid * 64 + lane;
    const int bh = unit >> 6, c = unit & 63, b = bh >> 4, h = bh & 15; const size_t row0 = (size_t)b * SEQ + 64 * c;
    const int cq = tid & 31, tg = tid >> 5, j = tg >> 2, pos = tg & 3;
    const int J = wid >> 1, vh = wid & 1, tl = lane & 15, g = lane >> 4;
    const f32x4 one = (f32x4){1.f, 1.f, 1.f, 1.f};
    bf16x8 sf[4][4]; u32x2 gg[4];
    const size_t orow = row0 + 16 * J + tl;
    { const int sr = tid >> 4, sc = tid & 15; *(HLAS u32x4*)(lds + P3_V + sr * RSV + sc * 16) = I.v0; *(HLAS u32x4*)(lds + P3_V + (32 + sr) * RSV + sc * 16) = I.v1; }
    f32x4 kq[4], f[4];
#pragma unroll
    for (int i = 0; i < 4; ++i) { kq[i] = (f32x4){bflo(I.kw[i].x), bfhi(I.kw[i].x), bflo(I.kw[i].y), bfhi(I.kw[i].y)}; f[i] = one - kq[i]; }
    f32x4 pre[4], suf[4]; pre[0] = f[0]; pre[1] = f[0] * f[1]; pre[2] = pre[1] * f[2]; pre[3] = pre[2] * f[3];
    suf[3] = one; suf[2] = f[3]; suf[1] = f[3] * f[2]; suf[0] = suf[1] * f[1];
    HLAS f32x4* GT = (HLAS f32x4*)(lds + P3_GT);
    GT[tg * 32 + cq] = pre[3];
    HG_SYNC();
    f32x4 T[4], E = one, E2 = one;
#pragma unroll
    for (int qd = 0; qd < 4; ++qd) { f32x4 t = one;
#pragma unroll
        for (int m = 0; m < 4; ++m) { const f32x4 gq = GT[(4 * qd + m) * 32 + cq]; t = t * gq; if (qd == j && m < pos) E = E * gq; if (qd == j && m > pos) E2 = E2 * gq; }
        T[qd] = t; }
    f32x4 H = one;
#pragma unroll
    for (int qd = 0; qd < 3; ++qd) if (qd < j) H = H * T[qd];
    const f32x4 T1 = (j == 0) ? T[1] : (j == 1) ? T[2] : T[3];
    const f32x4 T2 = (j == 0) ? T[2] : T[3];
#pragma unroll
    for (int i = 0; i < 4; ++i) { const int t = 4 * tg + i;
        const f32x4 p = E * pre[i], q = (f32x4){bflo(I.qw[i].x), bfhi(I.qw[i].x), bflo(I.qw[i].y), bfhi(I.qw[i].y)}, kk = kq[i];
        const f32x4 qh = q * p, qt = qh * H;
        f32x4 w0; w0.x = kk.x * __builtin_amdgcn_rcpf(p.x); w0.y = kk.y * __builtin_amdgcn_rcpf(p.y); w0.z = kk.z * __builtin_amdgcn_rcpf(p.z); w0.w = kk.w * __builtin_amdgcn_rcpf(p.w);
        const f32x4 w1 = kk * suf[i] * E2, w2 = w1 * T1, w3 = w2 * T2;
        u32x2 o; o.x = cvtpk(qh.x, qh.y); o.y = cvtpk(qh.z, qh.w); *(HLAS u32x2*)(lds + P3_QH + t * RSQ + cq * 8) = o;
        o.x = cvtpk(qt.x, qt.y); o.y = cvtpk(qt.z, qt.w); *(HLAS u32x2*)(lds + P3_QT + t * RSQ + cq * 8) = o;
        o.x = cvtpk(w0.x, w0.y); o.y = cvtpk(w0.z, w0.w); *(HLAS u32x2*)(lds + P3_W + (wbase(j) + t) * RSQ + cq * 8) = o;
        if (j < 3) { o.x = cvtpk(w1.x, w1.y); o.y = cvtpk(w1.z, w1.w); *(HLAS u32x2*)(lds + P3_W + (wbase(j + 1) + t) * RSQ + cq * 8) = o; }
        if (j < 2) { o.x = cvtpk(w2.x, w2.y); o.y = cvtpk(w2.z, w2.w); *(HLAS u32x2*)(lds + P3_W + (wbase(j + 2) + t) * RSQ + cq * 8) = o; }
        if (j < 1) { o.x = cvtpk(w3.x, w3.y); o.y = cvtpk(w3.z, w3.w); *(HLAS u32x2*)(lds + P3_W + (wbase(j + 3) + t) * RSQ + cq * 8) = o; } }
    if (prefetched) asm volatile("s_waitcnt vmcnt(10)" ::: "memory"); else asm volatile("s_waitcnt vmcnt(0)" ::: "memory");
    HG_SYNC();
    f32x4 gwv[4];
#pragma unroll
    for (int vt = 0; vt < 4; ++vt) { gg[vt] = *(const HGAS u32x2*)(GH + orow * HGD + h * 128 + 64 * vh + 16 * vt + 4 * g); gwv[vt] = *(const HGAS f32x4*)(gout + h * 128 + 64 * vh + 16 * vt + 4 * g); }
    bf16x8 qf[4];
#pragma unroll
    for (int k4 = 0; k4 < 4; ++k4) qf[k4] = *(const HLAS bf16x8*)(lds + P3_QH + (16 * J + tl) * RSQ + (32 * k4 + 8 * g) * 2);
    f32x4 X[4];
#pragma unroll
    for (int i = 0; i < 4; ++i) { X[i] = (f32x4){0.f, 0.f, 0.f, 0.f};
        if (i <= J) {
#pragma unroll
            for (int k4 = 0; k4 < 4; ++k4) { const bf16x8 wf = *(const HLAS bf16x8*)(lds + P3_W + (wbase(J) + 16 * i + tl) * RSQ + (32 * k4 + 8 * g) * 2);
                X[i] = __builtin_amdgcn_mfma_f32_16x16x32_bf16(wf, qf[k4], X[i], 0, 0, 0); }
            if (i == J) {
#pragma unroll
                for (int r = 0; r < 4; ++r) if (4 * g + r > tl) X[i][r] = 0.f; } } }
    bf16x8 Bf[2];
    { u32x4 w; w.x = cvtpk(X[0][0], X[0][1]); w.y = cvtpk(X[0][2], X[0][3]); w.z = cvtpk(X[1][0], X[1][1]); w.w = cvtpk(X[1][2], X[1][3]); Bf[0] = __builtin_bit_cast(bf16x8, w);
      w.x = cvtpk(X[2][0], X[2][1]); w.y = cvtpk(X[2][2], X[2][3]); w.z = cvtpk(X[3][0], X[3][1]); w.w = cvtpk(X[3][2], X[3][3]); Bf[1] = __builtin_bit_cast(bf16x8, w); }
#pragma unroll
    for (int k4 = 0; k4 < 4; ++k4) qf[k4] = *(const HLAS bf16x8*)(lds + P3_QT + (16 * J + tl) * RSQ + (32 * k4 + 8 * g) * 2);
    { HLAS const char* sbase = lds + (vh ? P3_S1 : P3_S0) + tl * 256;
#pragma unroll
      for (int vt = 0; vt < 4; ++vt)
#pragma unroll
          for (int k4 = 0; k4 < 4; ++k4) sf[vt][k4] = *(const HLAS bf16x8*)(sbase + vt * 4096 + (((4 * k4 + g) ^ tl) & 15) * 16); }
    f32x4 O[4]; float ss = 0.f;
    const int vtr = (int)(unsigned)(uintptr_t)(lds + P3_V) + (4 * g + (tl >> 2)) * RSV + (64 * vh + 4 * (lane & 3)) * 2;
#pragma unroll
    for (int vt = 0; vt < 4; ++vt) { O[vt] = (f32x4){0.f, 0.f, 0.f, 0.f};
#pragma unroll
        for (int k4 = 0; k4 < 4; ++k4) O[vt] = __builtin_amdgcn_mfma_f32_16x16x32_bf16(sf[vt][k4], qf[k4], O[vt], 0, 0, 0);
#pragma unroll
        for (int p = 0; p < 2; ++p) if (2 * p <= J) { s16x4 lo, hi2;
            asm volatile("ds_read_b64_tr_b16 %0, %1" : "=&v"(lo) : "v"(vtr + (32 * p) * RSV + (16 * vt) * 2) : "memory");
            asm volatile("ds_read_b64_tr_b16 %0, %1" : "=&v"(hi2) : "v"(vtr + (32 * p + 16) * RSV + (16 * vt) * 2) : "memory");
            asm volatile("s_waitcnt lgkmcnt(0)" ::: "memory"); __builtin_amdgcn_sched_barrier(0);
            const bf16x8 vf = {lo[0], lo[1], lo[2], lo[3], hi2[0], hi2[1], hi2[2], hi2[3]};
            O[vt] = __builtin_amdgcn_mfma_f32_16x16x32_bf16(vf, Bf[p], O[vt], 0, 0, 0); }
        ss += (O[vt][0] * O[vt][0] + O[vt][1] * O[vt][1]) + (O[vt][2] * O[vt][2] + O[vt][3] * O[vt][3]); }
    ss += __shfl_xor(ss, 16); ss += __shfl_xor(ss, 32);
    HLAS float* SS = (HLAS float*)(lds + P3_SS);
    if (g == 0) SS[vh * 64 + 16 * J + tl] = ss;
    HG_SYNC();
    f32x4 fac[4];
#pragma unroll
    for (int vt = 0; vt < 4; ++vt) fac[vt] = (f32x4){gwv[vt].x * bflo(gg[vt].x), gwv[vt].y * bfhi(gg[vt].x), gwv[vt].z * bflo(gg[vt].y), gwv[vt].w * bfhi(gg[vt].y)};
    asm volatile("" :: "v"(fac[0].x), "v"(fac[0].y), "v"(fac[0].z), "v"(fac[0].w), "v"(fac[1].x), "v"(fac[1].y), "v"(fac[1].z), "v"(fac[1].w), "v"(fac[2].x), "v"(fac[2].y), "v"(fac[2].z), "v"(fac[2].w), "v"(fac[3].x), "v"(fac[3].y), "v"(fac[3].z), "v"(fac[3].w) : "memory");
    __builtin_amdgcn_sched_barrier(0);
    if (next_unit >= 0) pass3_sdma(ST, next_unit, lds, wid, lane);
    const float tot = SS[16 * J + tl] + SS[64 + 16 * J + tl];
    const float rstd = 1.0f / sqrtf(tot * (1.0f / 128.0f) + 1e-6f);
#pragma unroll
    for (int vt = 0; vt < 4; ++vt) { const int v4 = 64 * vh + 16 * vt + 4 * g;
        u32x2 o; o.x = cvtpk(O[vt][0] * rstd * fac[vt].x, O[vt][1] * rstd * fac[vt].y); o.y = cvtpk(O[vt][2] * rstd * fac[vt].z, O[vt][3] * rstd * fac[vt].w);
        *(HGAS u32x2*)(MIX + orow * 4096 + 2048 + h * 128 + v4) = o; }
    HG_SYNC();
}
__device__ __forceinline__ void pass3_all(const bf16_t* KF, const bf16_t* QH, const bf16_t* VH, const bf16_t* GH, const bf16_t* ST, const float* gout, bf16_t* MIX, int u0, int ustride, HLAS char* lds, int wid_in) {
    const int wid = __builtin_amdgcn_readfirstlane(wid_in), lane = hw_lane(), tid = wid * 64 + lane;
    P3In A, B;
    int u = u0;
    if (u < NUNIT) { pass3_sdma(ST, u, lds, wid, lane); pass3_load(A, KF, QH, VH, u, tid); }
    while (u < NUNIT) {
        const int u2 = u + ustride, u3 = u2 + ustride;
        if (u2 < NUNIT) pass3_load(B, KF, QH, VH, u2, tid);
        pass3_compute(A, GH, ST, gout, MIX, u, u2 < NUNIT ? u2 : -1, u2 < NUNIT, lds, wid, lane);
        if (u2 >= NUNIT) break;
        if (u3 < NUNIT) pass3_load(A, KF, QH, VH, u3, tid);
        pass3_compute(B, GH, ST, gout, MIX, u2, u3 < NUNIT ? u3 : -1, u3 < NUNIT, lds, wid, lane);
        u = u3;
    }
}
}

constexpr int NWAVES = 8;
#ifndef MK_ONE_LAUNCH
#define MK_ONE_LAUNCH 1
#endif
constexpr int N_PHASES = 14;
#ifndef PROBE_DUP
#define PROBE_DUP -1
#endif
constexpr int BATCH = 4, SEQ = 4096, DM = 4096, M = BATCH * SEQ, DFF = 16384, PLE = 256;
constexpr int QLORA = 768, KVLORA = 512, HGD = 2048, INW = 9536, INWP = 9728;
constexpr float EPS = 1e-6f;
constexpr float QSCALE = 0.07216878364870322f * 1.4426950408889634f;
constexpr size_t MiB = 1u << 20;
constexpr size_t WS_CTL = 0, CTL_ZERO_BYTES = 64 * 1024;
constexpr size_t WS_RSX = 1 * MiB, WS_RSQ = WS_RSX + 65536, WS_RSKV = WS_RSQ + 65536, WS_RS1 = WS_RSKV + 65536, WS_RS2 = WS_RS1 + 65536, WS_RSE = WS_RS2 + 65536, WS_LB = WS_RSE + 65536;
constexpr size_t WS_RC = 2 * MiB, WS_RSN = 4 * MiB, WS_KRAW = 6 * MiB, WS_KR = 10 * MiB, WS_PB = 12 * MiB;
constexpr size_t WS_WIN = 20 * MiB, WS_WUQ = 96 * MiB, WS_WUKV = 101 * MiB, WS_WO = 105 * MiB, WS_WPG = 137 * MiB, WS_WPLE = 169 * MiB;
constexpr size_t WS_A = 172 * MiB;
constexpr size_t WS_MIX = 940 * MiB;
constexpr size_t WS_B = 300 * MiB;
constexpr size_t WS_C = 428 * MiB;
constexpr size_t WS_D = 556 * MiB;
constexpr size_t WS_E = 684 * MiB;
constexpr size_t WS_F = 812 * MiB;
constexpr size_t WS_CQ = WS_F, WS_CKV = WS_F + 24 * MiB, WS_QH = WS_F + 40 * MiB, WS_HID = WS_F, WS_DD = WS_F + 104 * MiB  , WS_END = WS_F + 256 * MiB;
static_assert(WS_WIN + (size_t)INWP * DM * 2 <= WS_WUQ && WS_WPLE + (size_t)DM * PLE * 2 <= WS_A && WS_END == 1068 * MiB, "d_ws map");
constexpr int RING_OFF = 0, RING_BYTES = 131072, LDSCTL_OFF = RING_BYTES, MISC_OFF = LDSCTL_OFF + 320, LDS_BYTES = 148480;

#define GAS __attribute__((address_space(1)))
#define LAS __attribute__((address_space(3)))
typedef unsigned short bf16;
typedef unsigned v4u __attribute__((ext_vector_type(4)));
typedef unsigned v2u __attribute__((ext_vector_type(2)));
typedef float f32x4 __attribute__((ext_vector_type(4)));
typedef float f32x2 __attribute__((ext_vector_type(2)));
typedef GAS unsigned gu32;
#define RLX_AGENT __ATOMIC_RELAXED, __HIP_MEMORY_SCOPE_AGENT
#define LDS_WAIT() asm volatile("s_waitcnt lgkmcnt(0)" ::: "memory")
__device__ __forceinline__ unsigned pk2(float lo, float hi) { unsigned r; asm volatile("s_nop 0\n\tv_cvt_pk_bf16_f32 %0, %1, %2" : "=v"(r) : "v"(lo), "v"(hi)); return r; }
__device__ __forceinline__ float bf_lo(unsigned w) { return __uint_as_float(w << 16); }
__device__ __forceinline__ float bf_hi(unsigned w) { return __uint_as_float(w & 0xffff0000u); }

#define XB_TMO      128
#define XB_XCNT(j)  (256  + 64 * (j))
#define XB_XSUB(j)  (1280 + 64 * (j))
#define XB_XGEN(j)  (2304 + 64 * (j))
#define XB_TOP      3328
#define XB_TOPGEN   3392
#define XCD_BAR_WORDS 3456
#define XB_SPIN_CAP (1u << 18)

__device__ __forceinline__ unsigned xb_ld(unsigned* p)              { return __hip_atomic_load(p, __ATOMIC_RELAXED, __HIP_MEMORY_SCOPE_AGENT); }
__device__ __forceinline__ unsigned xb_add(unsigned* p, unsigned v) { return __hip_atomic_fetch_add(p, v, __ATOMIC_RELAXED, __HIP_MEMORY_SCOPE_AGENT); }
__device__ __forceinline__ unsigned xb_xcc_id() { return (unsigned)__builtin_amdgcn_s_getreg((3 << 11) | 20) & 0xFu; }
#define XB_SPIN(cond, bar) do { unsigned _sp = 0; while (cond) { __builtin_amdgcn_s_sleep(1); \
    if ((++_sp & 255u) == 0u) { if (xb_ld(&(bar)[XB_TMO])) break; if (_sp > XB_SPIN_CAP) { atomicAdd(&(bar)[XB_TMO], 1u); break; } } } } while (0)

struct XcdBarrier {
    int wave;
    unsigned* bar; unsigned x;
    volatile LAS unsigned* st;
};

__device__ __forceinline__ XcdBarrier xcd_barrier_post(unsigned* bar, volatile LAS unsigned* st, int wave) {
    XcdBarrier b; b.wave = wave; b.bar = bar; b.x = xb_xcc_id(); b.st = st;
    if (wave == 0 && hw_lane() == 0) (void)xb_add(&bar[XB_XCNT(b.x)], 1u);
    return b;
}
__device__ __forceinline__ void xcd_barrier_complete(unsigned* bar, unsigned x, unsigned& nloc, unsigned& nx) {
    const unsigned G = gridDim.x * gridDim.y * gridDim.z;
    unsigned sum, cnt, mine, sp = 0u;
    for (;;) {
        sum = 0u; cnt = 0u; mine = 0u;
#pragma unroll
        for (unsigned j = 0; j < 16; ++j) { const unsigned c = xb_ld(&bar[XB_XCNT(j)]); sum += c; cnt += (c > 0u) ? 1u : 0u; mine = (j == x) ? c : mine; }
        if (sum == G) break;
        __builtin_amdgcn_s_sleep(1);
        if ((++sp & 255u) == 0u) { if (xb_ld(&bar[XB_TMO])) break; if (sp > XB_SPIN_CAP) { atomicAdd(&bar[XB_TMO], 1u); break; } }
    }
    nloc = mine > 0u ? mine : 1u; nx = cnt > 0u ? cnt : 1u;
}

__device__ __forceinline__ void xcd_barrier(const XcdBarrier& b) {
    asm volatile("s_waitcnt vmcnt(0)" ::: "memory");
    __syncthreads();
    if (b.wave == 0 && hw_lane() == 0) {
        unsigned* bar = b.bar;
        __builtin_amdgcn_s_waitcnt(0);
        unsigned nloc = b.st[0], nx = b.st[1];
        if (nloc == 0u) { xcd_barrier_complete(bar, b.x, nloc, nx); b.st[0] = nloc; b.st[1] = nx; }
        const unsigned old = xb_add(&bar[XB_XSUB(b.x)], 1u);
        const unsigned gen = old / nloc;
        if (old + 1u == (gen + 1u) * nloc) {
            __builtin_amdgcn_fence(__ATOMIC_RELEASE, "agent");
            asm volatile("s_waitcnt vmcnt(0)" ::: "memory");
            const unsigned og = xb_add(&bar[XB_TOP], 1u);
            const unsigned tg = og / nx;
            if (og + 1u == (tg + 1u) * nx) xb_add(&bar[XB_TOPGEN], 1u);
            else XB_SPIN(xb_ld(&bar[XB_TOPGEN]) == tg, bar);
            __builtin_amdgcn_fence(__ATOMIC_ACQUIRE, "agent");
            xb_add(&bar[XB_XGEN(b.x)], 1u);
            asm volatile("s_waitcnt vmcnt(0)" ::: "memory");
        } else {
            XB_SPIN(xb_ld(&bar[XB_XGEN(b.x)]) == gen, bar);
            __builtin_amdgcn_fence(__ATOMIC_ACQUIRE, "agent");
            asm volatile("s_waitcnt vmcnt(0)" ::: "memory");
        }
    }
    __syncthreads();
}

__device__ __forceinline__ float wave_sum(float v) {
#pragma unroll
    for (int o = 1; o < 64; o <<= 1) v += __shfl_xor(v, o);
    return v;
}
struct TrItem { f32x4 v[16]; };
__device__ __forceinline__ void tr_load(TrItem& T, const float* W, int N, int k0, int n0, const float* g, int lane, float wscale) {
    const float* p = W + (size_t)(k0 + (lane >> 4)) * N + n0 + 4 * (lane & 15);
#pragma unroll
    for (int i = 0; i < 16; ++i) { T.v[i] = __builtin_nontemporal_load((const GAS f32x4*)(p + (size_t)(4 * i) * N)); }
    if (g) {
#pragma unroll
        for (int i = 0; i < 16; ++i) T.v[i] = T.v[i] * (g[k0 + 4 * i + (lane >> 4)] * wscale); }
}
template <bool FP8>
__device__ __forceinline__ void tr_store(const TrItem& T, int K, bf16* WT, int k0, int drow0, LAS unsigned* scr, int lane) {
    const int r = lane >> 4, c = lane & 15;
#pragma unroll
    for (int i = 0; i < 16; ++i) { scr[(4 * i + r) * 33 + 2 * c] = pk2(T.v[i].x, T.v[i].y); scr[(4 * i + r) * 33 + 2 * c + 1] = pk2(T.v[i].z, T.v[i].w); }
    LDS_WAIT(); asm volatile("" ::: "memory");
    const int kc = lane & 7;
#pragma unroll
    for (int j = 0; j < 4; ++j) { const int np = 8 * j + (lane >> 3); unsigned d[8];
#pragma unroll
        for (int e = 0; e < 8; ++e) d[e] = scr[(8 * kc + e) * 33 + np];
        if constexpr (FP8) {
            int l0 = 0, l1 = 0, h0 = 0, h1 = 0;
            l0 = __builtin_amdgcn_cvt_pk_fp8_f32(bf_lo(d[0]), bf_lo(d[1]), l0, false); l0 = __builtin_amdgcn_cvt_pk_fp8_f32(bf_lo(d[2]), bf_lo(d[3]), l0, true);
            l1 = __builtin_amdgcn_cvt_pk_fp8_f32(bf_lo(d[4]), bf_lo(d[5]), l1, false); l1 = __builtin_amdgcn_cvt_pk_fp8_f32(bf_lo(d[6]), bf_lo(d[7]), l1, true);
            h0 = __builtin_amdgcn_cvt_pk_fp8_f32(bf_hi(d[0]), bf_hi(d[1]), h0, false); h0 = __builtin_amdgcn_cvt_pk_fp8_f32(bf_hi(d[2]), bf_hi(d[3]), h0, true);
            h1 = __builtin_amdgcn_cvt_pk_fp8_f32(bf_hi(d[4]), bf_hi(d[5]), h1, false); h1 = __builtin_amdgcn_cvt_pk_fp8_f32(bf_hi(d[6]), bf_hi(d[7]), h1, true);
            unsigned char* o = (unsigned char*)WT + (size_t)(drow0 + 2 * np) * K + k0 + 8 * kc;
            *(GAS v2u*)o = (v2u){(unsigned)l0, (unsigned)l1}; *(GAS v2u*)(o + K) = (v2u){(unsigned)h0, (unsigned)h1};
        } else {
        v4u lo, hi;
        lo.x = (d[0] & 0xffffu) | (d[1] << 16); lo.y = (d[2] & 0xffffu) | (d[3] << 16); lo.z = (d[4] & 0xffffu) | (d[5] << 16); lo.w = (d[6] & 0xffffu) | (d[7] << 16);
        hi.x = (d[0] >> 16) | (d[1] & 0xffff0000u); hi.y = (d[2] >> 16) | (d[3] & 0xffff0000u); hi.z = (d[4] >> 16) | (d[5] & 0xffff0000u); hi.w = (d[6] >> 16) | (d[7] & 0xffff0000u);
        bf16* o = WT + (size_t)(drow0 + 2 * np) * K + k0 + 8 * kc;
        *(GAS v4u*)o = lo; *(GAS v4u*)(o + K) = hi; } }
    LDS_WAIT(); asm volatile("" ::: "memory");
}
template <bool FP8 = false>
__device__ __forceinline__ void transpose_matrix(const float* W, int K, int N, bf16* WT, const float* g, LAS float* scrf, int gw, int NGW, int lane, bool is_win, float wscale = 1.0f) {
    LAS unsigned* scr = (LAS unsigned*)scrf;
    const int nblk = N / 64, nitems = (K / 64) * nblk;
    TrItem A, B;
#define TR_LD(X, it_) do { const int kb_ = (it_) / nblk, nb_ = (it_) - kb_ * nblk; tr_load(X, W, N, 64 * kb_, 64 * nb_, g, lane, wscale); } while (0)
#define TR_ST(X, it_) do { const int kb_ = (it_) / nblk, nb_ = (it_) - kb_ * nblk, n0_ = 64 * nb_; tr_store<FP8>(X, K, WT, 64 * kb_, (is_win && n0_ >= 1344) ? n0_ + 192 : n0_, scr, lane); } while (0)
    int it = gw;
    if (it < nitems) TR_LD(A, it);
    while (it < nitems) {
        const int it2 = it + NGW, it3 = it2 + NGW;
        if (it2 < nitems) TR_LD(B, it2);
        TR_ST(A, it);
        if (it2 >= nitems) break;
        if (it3 < nitems) TR_LD(A, it3);
        TR_ST(B, it2);
        it = it3;
    }
#undef TR_LD
#undef TR_ST
}
__device__ __forceinline__ float row_ss_bf16_4096(const bf16* row, int lane) {
    float s = 0.f;
#pragma unroll
    for (int j = 0; j < 8; ++j) { const v4u w = *(const GAS v4u*)(row + 8 * lane + 512 * j);
#pragma unroll
        for (int e = 0; e < 4; ++e) { const float a = bf_lo(w[e]), b = bf_hi(w[e]); s += a * a + b * b; } }
    return wave_sum(s);
}
__device__ __forceinline__ void rstd_rows_4096(const bf16* src, float* dst, int gw, int NGW, int lane) {
    for (int m = gw; m < M; m += NGW) { const float ss = row_ss_bf16_4096(src + (size_t)m * DM, lane); if (lane == 0) dst[m] = 1.0f / sqrtf(ss * (1.0f / DM) + EPS); }
}
__constant__ double ROPE_INVF[32] = {1.0, 0.7498942093324559, 0.5623413251903491, 0.4216965034285822, 0.31622776601683794, 0.23713737056616552, 0.1778279410038923, 0.1333521432163324, 0.1, 0.07498942093324558,
    0.05623413251903491, 0.042169650342858224, 0.03162277660168379, 0.023713737056616554, 0.01778279410038923, 0.01333521432163324, 0.01, 0.007498942093324558, 0.005623413251903491, 0.004216965034285823,
    0.0031622776601683794, 0.0023713737056616554, 0.0017782794100389228, 0.001333521432163324, 0.001, 0.0007498942093324559, 0.0005623413251903491, 0.00042169650342858224, 0.00031622776601683794,
    0.00023713737056616554, 0.00017782794100389227, 0.0001333521432163324};
__device__ __forceinline__ void rope_cs(int pos, int i, float& c, float& s) {
    const double th = (double)pos * ROPE_INVF[i];
    const double k = __builtin_rint(th * 0.6366197723675814);
    double r = __builtin_fma(-k, 1.5707963267948966, th); r = __builtin_fma(-k, 6.123233995736766e-17, r);
    const double r2 = r * r;
    double sp = -1.0 / 39916800.0; sp = __builtin_fma(sp, r2, 1.0 / 362880.0); sp = __builtin_fma(sp, r2, -1.0 / 5040.0); sp = __builtin_fma(sp, r2, 1.0 / 120.0); sp = __builtin_fma(sp, r2, -1.0 / 6.0); sp = __builtin_fma(sp, r2, 1.0); sp *= r;
    double cp = 1.0 / 479001600.0; cp = __builtin_fma(cp, r2, -1.0 / 3628800.0); cp = __builtin_fma(cp, r2, 1.0 / 40320.0); cp = __builtin_fma(cp, r2, -1.0 / 720.0); cp = __builtin_fma(cp, r2, 1.0 / 24.0); cp = __builtin_fma(cp, r2, -0.5); cp = __builtin_fma(cp, r2, 1.0);
    const int q = (int)((long long)k & 3);
    const double sv = (q == 0) ? sp : (q == 1) ? cp : (q == 2) ? -sp : -cp;
    const double cv = (q == 0) ? cp : (q == 1) ? -sp : (q == 2) ? -cp : sp;
    c = (float)cv; s = (float)sv;
}


struct Args { const float* in[20]; float* out; unsigned char* ws; int ph_lo, ph_hi; };
__global__ void __launch_bounds__(NWAVES * 64, 2) hymba_fwd(Args args) {
    extern __shared__ __attribute__((aligned(16))) unsigned char lds_raw[];
    LAS unsigned char* lds = (LAS unsigned char*)lds_raw;
    const int wave = __builtin_amdgcn_readfirstlane((int)threadIdx.x >> 6);
#define lane hw_lane()
#define tid (wave * 64 + hw_lane())
    const int G = gridDim.x; const int bx = blockIdx.x; const int vcu = (G % 8 == 0) ? (bx % 8) * (G / 8) + bx / 8 : bx;
    const int gw = vcu * NWAVES + wave, NGW = G * NWAVES;
    gu32* ctl = (gu32*)(args.ws + WS_CTL);
#define x_in (args.in[0])
#define p_in (args.in[1])
#define positions ((const int*)args.in[2])
#define norm_mix (args.in[3])
#define w_in (args.in[4])
#define q_a_norm (args.in[5])
#define kv_a_norm (args.in[6])
#define w_uq (args.in[7])
#define w_ukv (args.in[8])
#define hg_lb (args.in[9])
#define hg_out_norm (args.in[10])
#define w_o (args.in[11])
#define norm_mlp (args.in[12])
#define w_up (args.in[13])
#define w_down (args.in[14])
#define norm_ple (args.in[15])
#define w_pg (args.in[16])
#define w_ple (args.in[17])
#define ple_post (args.in[18])
#define final_norm (args.in[19])
#define out (args.out)
#define RSX ((float*)(ws + WS_RSX))
#define RSQ ((float*)(ws + WS_RSQ))
#define RSKV ((float*)(ws + WS_RSKV))
#define RS1 ((float*)(ws + WS_RS1))
#define RS2 ((float*)(ws + WS_RS2))
#define RSE ((float*)(ws + WS_RSE))
#define LB ((float*)(ws + WS_LB))
#define RC ((float*)(ws + WS_RC))
#define RSN ((float*)(ws + WS_RSN))
#define KRAW ((float*)(ws + WS_KRAW))
#define KR ((bf16*)(ws + WS_KR))
#define PB ((bf16*)(ws + WS_PB))
#define WIN ((bf16*)(ws + WS_WIN))
#define WUQ ((bf16*)(ws + WS_WUQ))
#define WUKV ((bf16*)(ws + WS_WUKV))
#define WO ((bf16*)(ws + WS_WO))
#define WPG ((bf16*)(ws + WS_WPG))
#define WPLE ((bf16*)(ws + WS_WPLE))
#define H2F ((unsigned char*)(ws + WS_WIN))
#define XB ((bf16*)(ws + WS_A))
#define MIX ((bf16*)(ws + WS_MIX))
#define H2B ((bf16*)(ws + WS_A))
#define KV ((bf16*)(ws + WS_B))
#define H1B ((bf16*)(ws + WS_B))
#define Q ((bf16*)(ws + WS_C))
#define WUP ((bf16*)(ws + WS_C))
#define WDN ((bf16*)(ws + WS_D))
#define VH ((bf16*)(ws + WS_E))
#define GH ((bf16*)(ws + WS_E + 64 * MiB))
#define EB ((bf16*)(ws + WS_E))
#define CQ ((bf16*)(ws + WS_CQ))
#define CKV ((bf16*)(ws + WS_CKV))
#define QH ((bf16*)(ws + WS_QH))
#define HID ((bf16*)(ws + WS_HID))
#define ws (args.ws)
#define FF ((bf16*)out)
#define UT ((bf16*)(ws + WS_D))
#define DDK ((float*)(ws + WS_DD))

    for (int u = tid; u < (LDS_BYTES - LDSCTL_OFF) / 4; u += NWAVES * 64) ((LAS unsigned*)(lds + LDSCTL_OFF))[u] = 0u;
    __syncthreads();
    volatile LAS unsigned* MISC = (volatile LAS unsigned*)(lds + MISC_OFF);
    XcdBarrier bar; bar.wave = wave; bar.bar = (unsigned*)(ctl + 1024); bar.x = 0; bar.st = nullptr;
    if (MK_ONE_LAUNCH) bar = xcd_barrier_post((unsigned*)(ctl + 1024), MISC + 8, wave);
    const int lo = args.ph_lo, hi = args.ph_hi;
#define IN(k) (lo <= (k) && (k) < hi)
#define SEAM(k) do { if (IN(k) && IN((k) + 1)) xcd_barrier(bar); } while (0)
    LAS float* scr = (LAS float*)(lds + RING_OFF + wave * 16384);

    if (IN(0)) {
        transpose_matrix(w_in, DM, INW, WIN, norm_mix, scr, gw, NGW, lane, true);
        transpose_matrix(w_uq, QLORA, 3072, WUQ, q_a_norm, scr, gw, NGW, lane, false);
        transpose_matrix(w_ukv, KVLORA, 4096, WUKV, kv_a_norm, scr, gw, NGW, lane, false);
        { const int gt = gw * 64 + lane, NGT = NGW * 64;
          for (int i = gt; i < 192 * DM / 8; i += NGT) *(GAS v4u*)(WIN + (size_t)1344 * DM + (size_t)i * 8) = (v4u){0u, 0u, 0u, 0u};
          for (int i = gt; i < M * 32; i += NGT) { float c, s; rope_cs(positions[i >> 5], i & 31, c, s); RC[i] = c; RSN[i] = s; }
          for (int i = gt; i < HGD; i += NGT) LB[i] = 1.0f / (1.0f + expf(hg_lb[HGD + i] - hg_lb[i]));
          for (int i = gt; i < M; i += NGT) { RS1[i] = 0.f; RS2[i] = 0.f; RSE[i] = 0.f; RSQ[i] = 0.f; RSKV[i] = 0.f; }
          for (int i = gt; i < M * PLE / 8; i += NGT) { const f32x4 a = *(const GAS f32x4*)(p_in + (size_t)i * 8), b = *(const GAS f32x4*)(p_in + (size_t)i * 8 + 4);
              *(GAS v4u*)(PB + (size_t)i * 8) = (v4u){pk2(a.x, a.y), pk2(a.z, a.w), pk2(b.x, b.y), pk2(b.z, b.w)}; } }
        for (int m = gw; m < M; m += NGW) { const GAS f32x4* xr = (const GAS f32x4*)(x_in + (size_t)m * DM) + lane; f32x4 v[16]; float s = 0.f;
#pragma unroll
            for (int j = 0; j < 16; ++j) { v[j] = __builtin_nontemporal_load(xr + 64 * j); s += (v[j].x * v[j].x + v[j].y * v[j].y) + (v[j].z * v[j].z + v[j].w * v[j].w); }
            s = wave_sum(s); if (lane == 0) RSX[m] = 1.0f / sqrtf(s * (1.0f / DM) + EPS);
            GAS v2u* o8 = (GAS v2u*)(XB + (size_t)m * DM) + lane;
#pragma unroll
            for (int j = 0; j < 16; ++j) o8[64 * j] = (v2u){pk2(v[j].x, v[j].y), pk2(v[j].z, v[j].w)}; }
    }
    SEAM(0);
    if (IN(1)) {
        pg8::Gemm g{XB, WIN, M, INWP, DM}; pg8::StaticOrder S; S.init(M, INWP, G, bx);
        pg8::EpiProj E{CQ, CKV, KRAW, QH, FF, VH, GH, RSX, LB, RSQ, RSKV};
        pg8::gemm_phase<pg8::EpiProj, pg8::StaticOrder, true, true>(lds + RING_OFF, g, S, E, wave);
        { const int nwg = (M / 256) * (INWP / 256), R = (nwg + G - 1) / G, nshort = R * G - nwg; const int first = (nshort == 0) ? 0 : G - nshort, cnt = (nshort == 0) ? G : nshort;
          if (bx >= first) { const int gw2 = (bx - first) * NWAVES + wave, NGW2 = cnt * NWAVES;
              transpose_matrix(w_o, DM, DM, WO, nullptr, scr, gw2, NGW2, lane, false);
              transpose_matrix<true>(w_pg, DM, DM, WPG, norm_ple, scr, gw2, NGW2, lane, false, 64.0f);
              transpose_matrix(w_ple, PLE, DM, WPLE, nullptr, scr, gw2, NGW2, lane, false); } }
    }
    SEAM(1);
    if (IN(2)) {
        for (int i = gw * 64 + lane; i < M * 32; i += NGW * 64) { const int m = i >> 5, l = i & 31;
            const float x1 = KRAW[(size_t)m * 64 + l], x2 = KRAW[(size_t)m * 64 + 32 + l], c = RC[i], sn = RSN[i];
            KR[(size_t)m * 64 + l] = (bf16)(pk2(x1 * c - x2 * sn, 0.f) & 0xffffu); KR[(size_t)m * 64 + 32 + l] = (bf16)(pk2(x2 * c + x1 * sn, 0.f) & 0xffffu); }
        hg::pass1_all(FF, VH, UT, DDK, vcu, G, (LAS char*)(lds + RING_OFF), wave);
    }
    SEAM(2);
    if (IN(3)) {
        { pg8::Gemm g{CQ, WUQ, M, 3072, QLORA}; pg8::StaticOrder S; S.init(M, 3072, G, bx); pg8::EpiRowScale E{Q, 3072, RSQ, QSCALE, nullptr, 1.0f / QLORA, EPS};
          pg8::gemm_phase<pg8::EpiRowScale, pg8::StaticOrder, true, true>(lds + RING_OFF, g, S, E, wave); }
        { pg8::Gemm g{CKV, WUKV, M, 4096, KVLORA}; pg8::StaticOrder S; S.init(M, 4096, G, bx); pg8::EpiRowScale E{KV, 4096, RSKV, 1.0f, nullptr, 1.0f / KVLORA, EPS};
          pg8::gemm_phase<pg8::EpiRowScale, pg8::StaticOrder, true, true>(lds + RING_OFF, g, S, E, wave); }
        hg::pass2_scan(UT, DDK, gw * 64 + lane, NGW * 64);
    }
    SEAM(3);
    if (IN(4)) {
        const att::Tensors T{Q, KV, KR, RC, RSN, MIX};
        for (int pi = vcu; pi < 512; pi += G) { const int bh = pi >> 3, s = pi & 7; att::unit(T, bh, 15 - s, (LAS char*)(lds + RING_OFF), wave); att::unit(T, bh, s, (LAS char*)(lds + RING_OFF), wave); }
        hg::pass3_all(FF, QH, VH, GH, UT, hg_out_norm, MIX, vcu, G, (LAS char*)(lds + RING_OFF), wave);
    }
    SEAM(4);
    if (IN(5)) {
        const bool conv_first = (vcu & 1) != 0;
        if (conv_first) { transpose_matrix(w_up, DM, DFF, WUP, norm_mlp, scr, gw, NGW, lane, false); transpose_matrix(w_down, DFF, DM, WDN, nullptr, scr, gw, NGW, lane, false); __syncthreads(); }
        { pg8::Gemm g{MIX, WO, M, DM, DM}; pg8::StaticOrder S; S.init(M, DM, G, bx); pg8::EpiResidB E{XB, H1B, nullptr, DM, RS1, false, true};
          pg8::gemm_phase<pg8::EpiResidB, pg8::StaticOrder, true, true>(lds + RING_OFF, g, S, E, wave); }
        { pg8::Gemm g{PB, WPLE, M, DM, PLE}; pg8::StaticOrder S; S.init(M, DM, G, bx); pg8::EpiRowScale E{EB, DM, nullptr, 1.0f, RSE, 0.f, 0.f};
          pg8::gemm_phase<pg8::EpiRowScale, pg8::StaticOrder, true, true>(lds + RING_OFF, g, S, E, wave); }
        if (!conv_first) { transpose_matrix(w_up, DM, DFF, WUP, norm_mlp, scr, gw, NGW, lane, false); transpose_matrix(w_down, DFF, DM, WDN, nullptr, scr, gw, NGW, lane, false); }
    }
    SEAM(5);
    if (IN(7)) { pg8::Gemm g{H1B, WUP, M / 2, DFF, DM}; pg8::StaticOrder S; S.init(M / 2, DFF, G, bx); pg8::EpiRelu2 E{HID, DFF, RS1, 1.0f / DM, EPS};
        pg8::gemm_phase<pg8::EpiRelu2, pg8::StaticOrder, true, true, false, true>(lds + RING_OFF, g, S, E, wave); }
    SEAM(7);
    if (IN(8)) { pg8::Gemm g{HID, WDN, M / 2, DM, DFF}; pg8::StaticOrder S; S.init(M / 2, DM, G, bx); pg8::EpiResidB E{H1B, H2B, H2F, DM, RS2, true, false};
        pg8::gemm_phase<pg8::EpiResidB, pg8::StaticOrder, true, true, false, true>(lds + RING_OFF, g, S, E, wave); }
    SEAM(8);
    if (IN(9)) { pg8::Gemm g{H1B + (size_t)(M / 2) * DM, WUP, M / 2, DFF, DM}; pg8::StaticOrder S; S.init(M / 2, DFF, G, bx); pg8::EpiRelu2 E{HID, DFF, RS1 + M / 2, 1.0f / DM, EPS};
        pg8::gemm_phase<pg8::EpiRelu2, pg8::StaticOrder, true, true, false, true>(lds + RING_OFF, g, S, E, wave); }
    SEAM(9);
    if (IN(10)) { pg8::Gemm g{HID, WDN, M / 2, DM, DFF}; pg8::StaticOrder S; S.init(M / 2, DM, G, bx); pg8::EpiResidB E{H1B + (size_t)(M / 2) * DM, H2B + (size_t)(M / 2) * DM, H2F + (size_t)(M / 2) * DM, DM, RS2 + M / 2, true, false};
        pg8::gemm_phase<pg8::EpiResidB, pg8::StaticOrder, true, true, false, true>(lds + RING_OFF, g, S, E, wave); }
    SEAM(10);
    if (IN(12)) { pg8::Gemm g{(const bf16*)H2F, WPG, M, DM, DM / 2}; pg8::StaticOrder S; S.init(M, DM, G, bx); pg8::EpiGateOnly E{(unsigned char*)WUP, RS2, DM, 1.0f / 64.0f, 1.0f / DM, EPS};
        pg8::gemm_phase<pg8::EpiGateOnly, pg8::StaticOrder, true, true, true, true>(lds + RING_OFF, g, S, E, wave); }
    SEAM(12);
    if (IN(13)) {
        for (int m = gw; m < M; m += NGW) {
            const bf16* hr = H2B + (size_t)m * DM + 8 * lane; const unsigned char* gr = (const unsigned char*)WUP + (size_t)m * DM + 8 * lane; const bf16* er = EB + (size_t)m * DM + 8 * lane;
            v4u wh[8], we[8]; v2u wg[8];
#pragma unroll
            for (int j = 0; j < 8; ++j) { wh[j] = *(const GAS v4u*)(hr + 512 * j); wg[j] = *(const GAS v2u*)(gr + 512 * j); we[j] = *(const GAS v4u*)(er + 512 * j); }
            const float rse = 1.0f / sqrtf(RSE[m] * (1.0f / DM) + EPS);
            float h3[64]; float s = 0.f;
#pragma unroll
            for (int j = 0; j < 8; ++j) { const f32x4 p0 = *(const GAS f32x4*)(ple_post + 8 * lane + 512 * j), p1 = *(const GAS f32x4*)(ple_post + 8 * lane + 512 * j + 4);
#pragma unroll
                for (int e = 0; e < 4; ++e) { const float pl = e < 2 ? p0[2 * e] : p1[2 * e - 4], ph = e < 2 ? p0[2 * e + 1] : p1[2 * e - 3];
                    const unsigned gq = wg[j][e >> 1] >> (16 * (e & 1)); const float gl = (float)(gq & 0xffu) * (1.0f / 255.0f), gh = (float)((gq >> 8) & 0xffu) * (1.0f / 255.0f);
                    const float a = bf_lo(wh[j][e]) + gl * (bf_lo(we[j][e]) * rse * pl), b = bf_hi(wh[j][e]) + gh * (bf_hi(we[j][e]) * rse * ph);
                    h3[8 * j + 2 * e] = a; h3[8 * j + 2 * e + 1] = b; s += a * a + b * b; } }
            s = wave_sum(s); const float rstd = 1.0f / sqrtf(s * (1.0f / DM) + EPS);
            float* orow = out + (size_t)m * DM + 8 * lane;
#pragma unroll
            for (int j = 0; j < 8; ++j) { const f32x4 g0 = *(const GAS f32x4*)(final_norm + 8 * lane + 512 * j), g1 = *(const GAS f32x4*)(final_norm + 8 * lane + 512 * j + 4);
                f32x4 o0, o1; o0.x = h3[8 * j] * rstd * g0.x; o0.y = h3[8 * j + 1] * rstd * g0.y; o0.z = h3[8 * j + 2] * rstd * g0.z; o0.w = h3[8 * j + 3] * rstd * g0.w;
                o1.x = h3[8 * j + 4] * rstd * g1.x; o1.y = h3[8 * j + 5] * rstd * g1.y; o1.z = h3[8 * j + 6] * rstd * g1.z; o1.w = h3[8 * j + 7] * rstd * g1.w;
                __builtin_nontemporal_store(o0, (GAS f32x4*)(orow + 512 * j)); __builtin_nontemporal_store(o1, (GAS f32x4*)(orow + 512 * j + 4)); }
        }
    }
#undef IN
#undef SEAM
#undef lane
#undef tid
#undef x_in
#undef p_in
#undef positions
#undef norm_mix
#undef w_in
#undef q_a_norm
#undef kv_a_norm
#undef w_uq
#undef w_ukv
#undef hg_lb
#undef hg_out_norm
#undef w_o
#undef norm_mlp
#undef w_up
#undef w_down
#undef norm_ple
#undef w_pg
#undef w_ple
#undef ple_post
#undef final_norm
#undef out
#undef RSX
#undef RSQ
#undef RSKV
#undef RS1
#undef RS2
#undef RSE
#undef LB
#undef RC
#undef RSN
#undef KRAW
#undef KR
#undef PB
#undef WIN
#undef WUQ
#undef WUKV
#undef WO
#undef WPG
#undef WPLE
#undef H2F
#undef XB
#undef MIX
#undef H2B
#undef KV
#undef H1B
#undef Q
#undef WUP
#undef WDN
#undef VH
#undef GH
#undef EB
#undef CQ
#undef CKV
#undef QH
#undef HID
#undef ws
#undef FF
#undef UT
#undef DDK
}

extern "C" void kernel_launch(void* const* d_in, const int* in_sizes, int n_in, void* d_out, int out_size, void* d_ws, size_t ws_size, hipStream_t stream) {
    static int grid = 0;
    if (grid == 0) {
        if (n_in != 20 || in_sizes[0] != M * DM || out_size != M * DM || ws_size < WS_END) { fprintf(stderr, "kernel_launch: unexpected shapes (n_in %d, in0 %d, out %d, ws %zu); nothing launched\n", n_in, n_in > 0 ? in_sizes[0] : -1, out_size, ws_size); grid = -1; return; }
        int dev = 0, cus = 0, per_cu = 0;
        if (hipGetDevice(&dev) != hipSuccess || hipDeviceGetAttribute(&cus, hipDeviceAttributeMultiprocessorCount, dev) != hipSuccess) { grid = -1; return; }
        if (hipFuncSetAttribute((const void*)hymba_fwd, hipFuncAttributeMaxDynamicSharedMemorySize, LDS_BYTES) != hipSuccess) { fprintf(stderr, "kernel_launch: hipFuncSetAttribute failed\n"); grid = -1; return; }
        if (hipOccupancyMaxActiveBlocksPerMultiprocessor(&per_cu, (const void*)hymba_fwd, NWAVES * 64, LDS_BYTES) != hipSuccess || per_cu < 1) fprintf(stderr, "kernel_launch: occupancy query reports %d workgroups per CU\n", per_cu);
        (void)hipGetLastError();
        grid = cus;
    }
    if (grid < 0) return;
    if (hipMemsetAsync((char*)d_ws + WS_CTL, 0, CTL_ZERO_BYTES, stream) != hipSuccess) return;
    Args a{};
    for (int i = 0; i < 20; ++i) a.in[i] = (const float*)d_in[i];
    a.out = (float*)d_out; a.ws = (unsigned char*)d_ws;
#if PROBE_DUP >= 0
    a.ph_lo = 0; a.ph_hi = PROBE_DUP + 1;
    hipLaunchKernelGGL(hymba_fwd, dim3(grid), dim3(NWAVES * 64), LDS_BYTES, stream, a);
    (void)hipMemsetAsync((char*)d_ws + WS_CTL, 0, CTL_ZERO_BYTES, stream);
    a.ph_lo = PROBE_DUP; a.ph_hi = N_PHASES;
    hipLaunchKernelGGL(hymba_fwd, dim3(grid), dim3(NWAVES * 64), LDS_BYTES, stream, a);
#elif MK_ONE_LAUNCH
    a.ph_lo = 0; a.ph_hi = N_PHASES;
    hipLaunchKernelGGL(hymba_fwd, dim3(grid), dim3(NWAVES * 64), LDS_BYTES, stream, a);
#else
    for (int li = 0; li < N_PHASES; ++li) { a.ph_lo = li; a.ph_hi = li + 1; hipLaunchKernelGGL(hymba_fwd, dim3(grid), dim3(NWAVES * 64), LDS_BYTES, stream, a); }
#endif
}
```

```cpp
#include <hip/hip_runtime.h>
#include <cstdio>
#include <cstdint>
__device__ __forceinline__ int hw_lane() { int l; asm volatile("v_mbcnt_lo_u32_b32 %0, -1, 0\n\tv_mbcnt_hi_u32_b32 %0, -1, %0" : "=v"(l)); return l; }
namespace pg8 {
#define PG8_LAS __attribute__((address_space(3)))
typedef unsigned short bf16_t;
typedef short bf16x8 __attribute__((ext_vector_type(8)));
typedef float f32x4 __attribute__((ext_vector_type(4)));
typedef unsigned u32x4 __attribute__((ext_vector_type(4)));
typedef int v4i32 __attribute__((ext_vector_type(4)));
typedef int v8i32 __attribute__((ext_vector_type(8)));
constexpr int BM = 256, BK = 64, HALF = 128, HTB = HALF * BK * 2  , STAGE_BYTES = 8 * HTB, NXCD = 8, WGM = 8;

__host__ __device__ __forceinline__ int lds_byte(int r, int c) { const int st = (r >> 4) * 2 + (c >> 5), rr = r & 15, cc = c & 31, ob = rr * 64 + cc * 2; return st * 1024 + (ob ^ (((ob >> 9) & 1) << 5)); }
__host__ __device__ __forceinline__ void stage_rc(int b, int& R, int& C) { const int st = b / 1024, sb = b % 1024, swz = sb ^ (((sb >> 9) & 1) << 5); R = (st >> 1) * 16 + swz / 64; C = (st & 1) * 32 + (swz % 64) / 2; }
__host__ __device__ __forceinline__ int perm32(int rho) { const int n = rho >> 4, i = rho & 15; return 8 * (i >> 2) + 4 * n + (i & 3); }

struct Unit { int pm, pn; };
struct Gemm { const bf16_t* A; const bf16_t* Bt; int M, N, K; };

struct StaticOrder {
    int nM, nN, nwg, G, c;
    __host__ __device__ void init(int M, int N, int G_, int c_) { nM = M / BM; nN = N / BM; nwg = nM * nN; G = G_; c = c_; }
    __host__ __device__ bool next(int i, Unit& u) const {
        const long L = (long)i * G + c; if (L >= nwg) return false;
        int wgid = (int)L; { const int q = nwg / NXCD, r = nwg % NXCD, xcd = wgid % NXCD, off = wgid / NXCD; wgid = (xcd < r ? xcd * (q + 1) : r * (q + 1) + (xcd - r) * q) + off; }
        const int nig = WGM * nN, gid = wgid / nig, fm = gid * WGM, gsz = (nM - fm) < WGM ? (nM - fm) : WGM;
        u.pm = fm + ((wgid % nig) % gsz); u.pn = (wgid % nig) / gsz; return true;
    }
    __device__ __forceinline__ void a_ready(const Unit&) const {}
    __device__ __forceinline__ void done(const Unit&) const {}
};

__device__ __forceinline__ unsigned cvt_pk_bf16(float lo, float hi) { unsigned r; asm volatile("s_nop 0\n\tv_cvt_pk_bf16_f32 %0, %1, %2" : "=v"(r) : "v"(lo), "v"(hi)); return r; }
typedef float f32x2 __attribute__((ext_vector_type(2)));
typedef unsigned u32x2 __attribute__((ext_vector_type(2)));
__device__ __forceinline__ float sigmoidf_(float z) { return __builtin_amdgcn_rcpf(1.0f + __builtin_amdgcn_exp2f(-1.4426950408889634f * z)); }
__device__ __forceinline__ u32x4 pack8(f32x4 a, f32x4 b) { u32x4 w; w.x = cvt_pk_bf16(a[0], a[1]); w.y = cvt_pk_bf16(a[2], a[3]); w.z = cvt_pk_bf16(b[0], b[1]); w.w = cvt_pk_bf16(b[2], b[3]); return w; }

__device__ __forceinline__ void row_sumsq_add(float* accp, float s, int fq) { s += __shfl_xor(s, 16); s += __shfl_xor(s, 32); if (fq == 0) atomicAdd(accp, s); }
__device__ __forceinline__ float sq4(f32x4 v) { return (v[0] * v[0] + v[1] * v[1]) + (v[2] * v[2] + v[3] * v[3]); }

__device__ __forceinline__ size_t tiled_off(int r, int c, int ldc) { return ((size_t)(r >> 4) * (ldc >> 5) + (c >> 5)) * 512 + (r & 15) * 32 + (c & 31); }
__device__ __forceinline__ size_t tiled_off8(int r, int c, int ldc) { return ((size_t)(r >> 4) * (ldc >> 6) + (c >> 6)) * 1024 + (r & 15) * 64 + (c & 63); }
struct EpiProj {
    static constexpr bool PERM = true, AFTER_DRAIN = false;
    bf16_t* CQ; bf16_t* CKV; float* KRAW; bf16_t* QH; bf16_t* KF; bf16_t* VH; bf16_t* GH; const float* rstd; const float* LB; float* ssq_q; float* ssq_kv;
    __device__ __forceinline__ void operator()(const f32x4 (&acc)[2][2][4][2], const Unit& u, int wr, int wc, int fr, int fq) const {
        const int row0 = u.pm * BM + wr * 64 + fr, t = u.pn, cl = wc * 32 + 8 * fq;
        int cat, cbase;
        if (t < 3) { cat = 0; cbase = t * 256; } else if (t < 5) { cat = 1; cbase = (t - 3) * 256; } else if (t == 5) { cat = 2; cbase = 0; }
        else if (t < 14) { cat = 3; cbase = (t - 6) * 256; } else if (t < 22) { cat = 4; cbase = (t - 14) * 256; } else if (t < 30) { cat = 5; cbase = (t - 22) * 256; } else { cat = 6; cbase = (t - 30) * 256; }
        float rs[2][4];
#pragma unroll
        for (int ai = 0; ai < 2; ++ai)
#pragma unroll
            for (int m = 0; m < 4; ++m) rs[ai][m] = rstd[row0 + ai * HALF + m * 16];
        f32x4 lb[2][2];
#pragma unroll
        for (int bj = 0; bj < 2; ++bj) { lb[bj][0] = (f32x4){0.f, 0.f, 0.f, 0.f}; lb[bj][1] = lb[bj][0]; if (cat == 4) { lb[bj][0] = *(const f32x4*)(LB + cbase + bj * HALF + cl); lb[bj][1] = *(const f32x4*)(LB + cbase + bj * HALF + cl + 4); } }
#pragma unroll
        for (int ai = 0; ai < 2; ++ai)
#pragma unroll
            for (int m = 0; m < 4; ++m) { const int row = row0 + ai * HALF + m * 16; const float rsv = rs[ai][m]; float qs = 0.f;
#pragma unroll
                for (int bj = 0; bj < 2; ++bj) { const int col = cbase + bj * HALF + cl; f32x4 v0 = acc[ai][bj][m][0] * rsv, v1 = acc[ai][bj][m][1] * rsv;
                    if (cat == 0) { *(u32x4*)(CQ + (size_t)row * 768 + col) = pack8(v0, v1); qs += sq4(v0) + sq4(v1); }
                    else if (cat == 1) { *(u32x4*)(CKV + (size_t)row * 512 + col) = pack8(v0, v1); qs += sq4(v0) + sq4(v1); }
                    else if (cat == 2) { if (bj == 0 && wc < 2) { *(f32x4*)(KRAW + (size_t)row * 64 + col) = v0; *(f32x4*)(KRAW + (size_t)row * 64 + col + 4) = v1; } }
                    else if (cat == 3 || cat == 6) {
#pragma unroll
                        for (int e = 0; e < 4; ++e) { v0[e] = v0[e] * sigmoidf_(v0[e]); v1[e] = v1[e] * sigmoidf_(v1[e]); }
                        *(u32x4*)((cat == 3 ? QH : GH) + (size_t)row * 2048 + col) = pack8(v0, v1); }
                    else if (cat == 4) { const f32x4 l0 = lb[bj][0], l1 = lb[bj][1];
#pragma unroll
                        for (int e = 0; e < 4; ++e) { v0[e] = (1.0f - l0[e]) * sigmoidf_(-v0[e]); v1[e] = (1.0f - l1[e]) * sigmoidf_(-v1[e]); }
                        *(u32x4*)(KF + (size_t)row * 2048 + col) = pack8(v0, v1); }
                    else { *(u32x4*)(VH + (size_t)row * 2048 + col) = pack8(v0, v1); }
                }
                if (cat == 0) row_sumsq_add(ssq_q + row, qs, fq); else if (cat == 1) row_sumsq_add(ssq_kv + row, qs, fq); }
    }
};
struct EpiRowScale {
    static constexpr bool PERM = true, AFTER_DRAIN = false;
    bf16_t* O; int ldc; const float* rs; float scale; float* ssq; float inv_n, eps;
    __device__ __forceinline__ void operator()(const f32x4 (&acc)[2][2][4][2], const Unit& u, int wr, int wc, int fr, int fq) const {
        const int row0 = u.pm * BM + wr * 64 + fr, col0 = u.pn * BM + wc * 32 + 8 * fq;
        float sv[2][4];
#pragma unroll
        for (int ai = 0; ai < 2; ++ai)
#pragma unroll
            for (int m = 0; m < 4; ++m) sv[ai][m] = (rs ? 1.0f / sqrtf(rs[row0 + ai * HALF + m * 16] * inv_n + eps) : 1.0f) * scale;
#pragma unroll
        for (int ai = 0; ai < 2; ++ai)
#pragma unroll
            for (int m = 0; m < 4; ++m) { const int row = row0 + ai * HALF + m * 16; const float s = sv[ai][m]; float q = 0.f;
#pragma unroll
                for (int bj = 0; bj < 2; ++bj) { const f32x4 v0 = acc[ai][bj][m][0] * s, v1 = acc[ai][bj][m][1] * s; q += sq4(v0) + sq4(v1);
                    *(u32x4*)(O + (size_t)row * ldc + col0 + bj * HALF) = pack8(v0, v1); }
                if (ssq) row_sumsq_add(ssq + row, q, fq); }
    }
};
struct EpiRelu2 {
    static constexpr bool PERM = true, AFTER_DRAIN = false;
    bf16_t* O; int ldc; const float* ssq; float inv_n, eps;
    __device__ __forceinline__ void operator()(const f32x4 (&acc)[2][2][4][2], const Unit& u, int wr, int wc, int fr, int fq) const {
        const int row0 = u.pm * BM + wr * 64 + fr, col0 = u.pn * BM + wc * 32 + 8 * fq;
        float sv[2][4];
#pragma unroll
        for (int ai = 0; ai < 2; ++ai)
#pragma unroll
            for (int m = 0; m < 4; ++m) sv[ai][m] = 1.0f / sqrtf(ssq[row0 + ai * HALF + m * 16] * inv_n + eps);
#pragma unroll
        for (int ai = 0; ai < 2; ++ai)
#pragma unroll
            for (int m = 0; m < 4; ++m) { const int row = row0 + ai * HALF + m * 16; const float s = sv[ai][m];
#pragma unroll
                for (int bj = 0; bj < 2; ++bj) { f32x4 v0 = acc[ai][bj][m][0] * s, v1 = acc[ai][bj][m][1] * s;
#pragma unroll
                    for (int e = 0; e < 4; ++e) { const float a = fmaxf(v0[e], 0.f), b = fmaxf(v1[e], 0.f); v0[e] = a * a; v1[e] = b * b; }
                    *(u32x4*)(O + ((size_t)(row >> 4) * (ldc >> 5) + ((col0 + bj * HALF) >> 5)) * 512 + (row & 15) * 32 + (col0 & 31)) = pack8(v0, v1); } }
    }
};
struct EpiResidX {
    static constexpr bool PERM = true, AFTER_DRAIN = false;
    const float* base; bf16_t* hb; int ldc; float* ssq;
    __device__ __forceinline__ void ldg(f32x4 (&b)[2][2][2], int grp, size_t off0) const {
#pragma unroll
        for (int mm = 0; mm < 2; ++mm)
#pragma unroll
            for (int bj = 0; bj < 2; ++bj)
#pragma unroll
                for (int n = 0; n < 2; ++n) b[mm][bj][n] = *(const f32x4*)(base + off0 + (size_t)((grp >> 1) * HALF + ((grp & 1) * 2 + mm) * 16) * ldc + bj * HALF + n * 4);
    }
    __device__ __forceinline__ void stg(const f32x4 (&b)[2][2][2], const f32x4 (&acc)[2][2][4][2], int grp, size_t off0, int row0, int fq) const {
        const int ai = grp >> 1;
#pragma unroll
        for (int mm = 0; mm < 2; ++mm) { const int m = (grp & 1) * 2 + mm; float q = 0.f;
#pragma unroll
            for (int bj = 0; bj < 2; ++bj) { const size_t o2 = off0 + (size_t)(ai * HALF + m * 16) * ldc + bj * HALF; const f32x4 v0 = b[mm][bj][0] + acc[ai][bj][m][0], v1 = b[mm][bj][1] + acc[ai][bj][m][1]; q += sq4(v0) + sq4(v1);
                *(u32x4*)(hb + o2) = pack8(v0, v1); }
            row_sumsq_add(ssq + row0 + ai * HALF + m * 16, q, fq); }
    }
    __device__ __forceinline__ void operator()(const f32x4 (&acc)[2][2][4][2], const Unit& u, int wr, int wc, int fr, int fq) const {
        const int row0 = u.pm * BM + wr * 64 + fr; const size_t off0 = (size_t)row0 * ldc + u.pn * BM + wc * 32 + 8 * fq;
        f32x4 b0[2][2][2], b1[2][2][2];
        ldg(b0, 0, off0); ldg(b1, 1, off0);
        stg(b0, acc, 0, off0, row0, fq); ldg(b0, 2, off0);
        stg(b1, acc, 1, off0, row0, fq); ldg(b1, 3, off0);
        stg(b0, acc, 2, off0, row0, fq); stg(b1, acc, 3, off0, row0, fq);
    }
};
__device__ __forceinline__ void unpack8(u32x4 w, f32x4& a, f32x4& b) {
    a[0] = __uint_as_float(w.x << 16); a[1] = __uint_as_float(w.x & 0xffff0000u); a[2] = __uint_as_float(w.y << 16); a[3] = __uint_as_float(w.y & 0xffff0000u);
    b[0] = __uint_as_float(w.z << 16); b[1] = __uint_as_float(w.z & 0xffff0000u); b[2] = __uint_as_float(w.w << 16); b[3] = __uint_as_float(w.w & 0xffff0000u);
}
struct EpiResidB {
    static constexpr bool PERM = true, AFTER_DRAIN = false;
    const bf16_t* hin; bf16_t* hout; unsigned char* hf8; int ldc; float* ssq; bool tin, tout;
    __device__ __forceinline__ void operator()(const f32x4 (&acc)[2][2][4][2], const Unit& u, int wr, int wc, int fr, int fq) const {
        const int row0 = u.pm * BM + wr * 64 + fr, col0 = u.pn * BM + wc * 32 + 8 * fq;
        u32x4 b[2][4][2];
#pragma unroll
        for (int ai = 0; ai < 2; ++ai)
#pragma unroll
            for (int m = 0; m < 4; ++m)
#pragma unroll
                for (int bj = 0; bj < 2; ++bj) { const int r = row0 + ai * HALF + m * 16, c = col0 + bj * HALF; b[ai][m][bj] = *(const u32x4*)(hin + (tin ? tiled_off(r, c, ldc) : (size_t)r * ldc + c)); }
#pragma unroll
        for (int ai = 0; ai < 2; ++ai)
#pragma unroll
            for (int m = 0; m < 4; ++m) { float q = 0.f;
#pragma unroll
                for (int bj = 0; bj < 2; ++bj) { f32x4 x0, x1; unpack8(b[ai][m][bj], x0, x1); x0 = x0 + acc[ai][bj][m][0]; x1 = x1 + acc[ai][bj][m][1]; q += sq4(x0) + sq4(x1);
                    const int r = row0 + ai * HALF + m * 16, c = col0 + bj * HALF;
                    *(u32x4*)(hout + (tout ? tiled_off(r, c, ldc) : (size_t)r * ldc + c)) = pack8(x0, x1);
                    if (hf8) { int w0 = 0, w1 = 0; w0 = __builtin_amdgcn_cvt_pk_fp8_f32(x0[0], x0[1], w0, false); w0 = __builtin_amdgcn_cvt_pk_fp8_f32(x0[2], x0[3], w0, true);
                        w1 = __builtin_amdgcn_cvt_pk_fp8_f32(x1[0], x1[1], w1, false); w1 = __builtin_amdgcn_cvt_pk_fp8_f32(x1[2], x1[3], w1, true);
                        u32x2 w; w.x = (unsigned)w0; w.y = (unsigned)w1; *(u32x2*)(hf8 + tiled_off8(r, c, ldc)) = w; } }
                row_sumsq_add(ssq + row0 + ai * HALF + m * 16, q, fq); }
    }
};
struct EpiGate {
    static constexpr bool PERM = true, AFTER_DRAIN = false;
    const bf16_t* hin; bf16_t* hout; const bf16_t* E; const float* rs2; const float* rse; const float* gpost; int ldc; float accscale; float inv_n, eps; bf16_t* Gout;
    struct Grp { u32x4 hb[2], eb[2]; float s2, se; };
    __device__ __forceinline__ void ldg(Grp& g, int grp, int row0, size_t off0) const {
        const int r = (grp >> 2) * HALF + (grp & 3) * 16; g.s2 = accscale / sqrtf(rs2[row0 + r] * inv_n + eps); g.se = 1.0f / sqrtf(rse[row0 + r] * inv_n + eps);
#pragma unroll
        for (int bj = 0; bj < 2; ++bj) { const size_t o2 = off0 + (size_t)r * ldc + bj * HALF; g.hb[bj] = *(const u32x4*)(hin + o2); g.eb[bj] = *(const u32x4*)(E + o2); }
    }
    __device__ __forceinline__ void stg(const Grp& g, const f32x4 (&acc)[2][2][4][2], const f32x4 (&gp)[2][2], int grp, size_t off0) const {
        const int ai = grp >> 2, m = grp & 3;
#pragma unroll
        for (int bj = 0; bj < 2; ++bj) { const size_t o2 = off0 + (size_t)(ai * HALF + m * 16) * ldc + bj * HALF; f32x4 h0, h1, e0, e1; unpack8(g.hb[bj], h0, h1); unpack8(g.eb[bj], e0, e1);
            const f32x4 a0 = acc[ai][bj][m][0] * g.s2, a1 = acc[ai][bj][m][1] * g.s2;
            f32x4 s0, s1;
#pragma unroll
            for (int e = 0; e < 4; ++e) { s0[e] = sigmoidf_(a0[e]); s1[e] = sigmoidf_(a1[e]); h0[e] += s0[e] * (e0[e] * g.se * gp[bj][0][e]); h1[e] += s1[e] * (e1[e] * g.se * gp[bj][1][e]); }
            *(u32x4*)(hout + o2) = pack8(h0, h1); *(u32x4*)(Gout + o2) = pack8(s0, s1); }
    }
    __device__ __forceinline__ void operator()(const f32x4 (&acc)[2][2][4][2], const Unit& u, int wr, int wc, int fr, int fq) const {
        const int row0 = u.pm * BM + wr * 64 + fr, col0 = u.pn * BM + wc * 32 + 8 * fq; const size_t off0 = (size_t)row0 * ldc + col0;
        f32x4 gp[2][2];
#pragma unroll
        for (int bj = 0; bj < 2; ++bj)
#pragma unroll
            for (int n = 0; n < 2; ++n) gp[bj][n] = *(const f32x4*)(gpost + col0 + bj * HALF + n * 4);
        Grp g0;
#pragma unroll
        for (int gi = 0; gi < 8; ++gi) { ldg(g0, gi, row0, off0); stg(g0, acc, gp, gi, off0); }
    }
};

struct EpiGateOnly {
    static constexpr bool PERM = true, AFTER_DRAIN = false;
    unsigned char* Gp; const float* ssq2; int ldc; float accscale, inv_n, eps;
    __device__ __forceinline__ void operator()(const f32x4 (&acc)[2][2][4][2], const Unit& u, int wr, int wc, int fr, int fq) const {
        const int row0 = u.pm * BM + wr * 64 + fr, col0 = u.pn * BM + wc * 32 + 8 * fq;
        float sv[2][4];
#pragma unroll
        for (int ai = 0; ai < 2; ++ai)
#pragma unroll
            for (int m = 0; m < 4; ++m) sv[ai][m] = accscale / sqrtf(ssq2[row0 + ai * HALF + m * 16] * inv_n + eps);
#pragma unroll
        for (int ai = 0; ai < 2; ++ai)
#pragma unroll
            for (int m = 0; m < 4; ++m) { const int row = row0 + ai * HALF + m * 16; const float s = sv[ai][m];
#pragma unroll
                for (int bj = 0; bj < 2; ++bj) { f32x4 v0 = acc[ai][bj][m][0] * s, v1 = acc[ai][bj][m][1] * s;
#pragma unroll
                    for (int e = 0; e < 4; ++e) { v0[e] = sigmoidf_(v0[e]) * 255.0f + 0.5f; v1[e] = sigmoidf_(v1[e]) * 255.0f + 0.5f; }
                    u32x2 w; w.x = (unsigned)v0[0] | ((unsigned)v0[1] << 8) | ((unsigned)v0[2] << 16) | ((unsigned)v0[3] << 24); w.y = (unsigned)v1[0] | ((unsigned)v1[1] << 8) | ((unsigned)v1[2] << 16) | ((unsigned)v1[3] << 24);
                    *(u32x2*)(Gp + (size_t)row * ldc + col0 + bj * HALF) = w; } }
    }
};

template <class Epi, class Sched, bool ALIGN_EPI = false, bool SP2 = false, bool FP8 = false, bool ATILED = false>
__device__ __forceinline__ void gemm_phase(PG8_LAS unsigned char* lds, const Gemm g, const Sched& S, const Epi& E, int wid_in) {
    const int wid = __builtin_amdgcn_readfirstlane(wid_in), lane = hw_lane(), tid = wid * 64 + lane, wr = wid >> 2, wc = wid & 3, fr = lane & 15, fq = lane >> 4;
    const int K = g.K, nt = K / BK;
    unsigned voffA[2], voffB[2];
#pragma unroll
    for (int i = 0; i < 2; ++i) { int R, C; stage_rc(tid * 16 + i * 8192, R, C); const int Rb = Epi::PERM ? ((R & ~31) + perm32(R & 31)) : R;
        voffA[i] = ATILED ? (unsigned)((R >> 4) * (K * 32) + (C >> 5) * 1024 + (R & 15) * 64 + (C & 31) * 2) : (unsigned)(R * K + C) * 2u; voffB[i] = (unsigned)(Rb * K + C) * 2u; }
    const size_t kstep = (size_t)(BK * 2);
    const size_t kstepA = ATILED ? (size_t)2048 : kstep;
    const size_t hstep = (size_t)HALF * K * 2;
    const size_t tstep = 2 * hstep;
    const unsigned ldsw = (unsigned)wid * 1024u, ldsbase = (unsigned)(uintptr_t)lds;
    const int aoff = lds_byte(wr * 64 + fr, fq * 8), boff = lds_byte(wc * 32 + fr, fq * 8);
#define PG8_SA(b, h) (((b) * 2 + (h)) * HTB)
#define PG8_SB(b, h) ((4 + (b) * 2 + (h)) * HTB)
#define PG8_STAGE(bufoff, gbase, voff) do { _Pragma("unroll") for (int _i = 0; _i < 2; ++_i) { unsigned keep_; \
        asm volatile("s_mov_b32 %0, m0\n\ts_mov_b32 m0, %1\n\ts_nop 0\n\tglobal_load_lds_dwordx4 %2, %3\n\ts_mov_b32 m0, %0" \
            : "=&s"(keep_) : "s"(ldsbase + (unsigned)((bufoff) + _i * 8192) + ldsw), "v"((voff)[_i]), "s"((const char*)(gbase)) : "memory"); } } while (0)
#define PG8_LDA(dst, b, h) do { _Pragma("unroll") for (int m = 0; m < 4; ++m) _Pragma("unroll") for (int k = 0; k < 2; ++k) dst[m][k] = *(const PG8_LAS bf16x8*)(lds + PG8_SA(b, h) + aoff + m * 2048 + k * 1024); } while (0)
#define PG8_LDB(dst, b, h) do { _Pragma("unroll") for (int n = 0; n < 2; ++n) _Pragma("unroll") for (int k = 0; k < 2; ++k) dst[n][k] = *(const PG8_LAS bf16x8*)(lds + PG8_SB(b, h) + boff + n * 2048 + k * 1024); } while (0)
#define PG8_MMA(ai, bj, At, Bt) do { __builtin_amdgcn_s_setprio(1); \
        if constexpr (FP8) { _Pragma("unroll") for (int m = 0; m < 4; ++m) _Pragma("unroll") for (int n = 0; n < 2; ++n) { \
            const v8i32 fb_ = __builtin_shufflevector(__builtin_bit_cast(v4i32, Bt[n][0]), __builtin_bit_cast(v4i32, Bt[n][1]), 0, 1, 2, 3, 4, 5, 6, 7), fa_ = __builtin_shufflevector(__builtin_bit_cast(v4i32, At[m][0]), __builtin_bit_cast(v4i32, At[m][1]), 0, 1, 2, 3, 4, 5, 6, 7); \
            acc[ai][bj][m][n] = __builtin_amdgcn_mfma_scale_f32_16x16x128_f8f6f4(fb_, fa_, acc[ai][bj][m][n], 0, 0, 0, 0x7f7f7f7f, 0, 0x7f7f7f7f); } } \
        else { _Pragma("unroll") for (int m = 0; m < 4; ++m) _Pragma("unroll") for (int n = 0; n < 2; ++n) _Pragma("unroll") for (int k = 0; k < 2; ++k) \
            acc[ai][bj][m][n] = __builtin_amdgcn_mfma_f32_16x16x32_bf16(Bt[n][k], At[m][k], acc[ai][bj][m][n], 0, 0, 0); } \
        __builtin_amdgcn_s_setprio(0); } while (0)
#define PG8_WAIT_V(n) asm volatile("s_waitcnt vmcnt(" #n ")" ::: "memory")
#define PG8_WAIT_L(n) asm volatile("s_waitcnt lgkmcnt(" #n ")" ::: "memory")
#define PG8_BAR __builtin_amdgcn_s_barrier()
#define PG8_SCHED __builtin_amdgcn_sched_barrier(0)
    Unit cur, nxt; int ui = 0;
    if (!S.next(0, cur)) return;
    f32x4 acc[2][2][4][2];
#pragma unroll
    for (int a = 0; a < 2; ++a)
#pragma unroll
        for (int b = 0; b < 2; ++b)
#pragma unroll
            for (int m = 0; m < 4; ++m)
#pragma unroll
                for (int n = 0; n < 2; ++n) acc[a][b][m][n] = (f32x4){0.f, 0.f, 0.f, 0.f};
    bf16x8 At[4][2], B0[2][2], B1[2][2];
    const char* cA = (const char*)g.A + (size_t)cur.pm * tstep; const char* cB = (const char*)g.Bt + (size_t)cur.pn * tstep;
    S.a_ready(cur);
    if constexpr (SP2) {
        PG8_STAGE(PG8_SB(0, 0), cB, voffB); PG8_STAGE(PG8_SB(0, 1), cB + hstep, voffB); PG8_STAGE(PG8_SA(0, 0), cA, voffA); PG8_STAGE(PG8_SA(0, 1), cA + hstep, voffA);
        if (wr == 1) PG8_BAR;
        PG8_WAIT_V(2); PG8_BAR;
        PG8_STAGE(PG8_SB(1, 0), cB + kstep, voffB); PG8_STAGE(PG8_SA(1, 0), cA + kstepA, voffA); PG8_STAGE(PG8_SB(1, 1), cB + hstep + kstep, voffB);
        PG8_WAIT_V(6); PG8_BAR;
    } else {
        PG8_STAGE(PG8_SB(0, 0), cB, voffB); PG8_STAGE(PG8_SA(0, 0), cA, voffA); PG8_STAGE(PG8_SB(0, 1), cB + hstep, voffB); PG8_STAGE(PG8_SA(0, 1), cA + hstep, voffA);
        if (wr == 1) PG8_BAR;
        PG8_WAIT_V(4); PG8_BAR;
        PG8_STAGE(PG8_SB(1, 0), cB + kstep, voffB); PG8_STAGE(PG8_SA(1, 0), cA + kstepA, voffA); PG8_STAGE(PG8_SB(1, 1), cB + hstep + kstep, voffB);
        PG8_WAIT_V(6); PG8_BAR;
    }
    for (;;) {
        const bool has_next = S.next(ui + 1, nxt);
        const char* nA = has_next ? (const char*)g.A + (size_t)nxt.pm * tstep : cA; const char* nB = has_next ? (const char*)g.Bt + (size_t)nxt.pn * tstep : cB;
        for (int t = 0; t < nt; t += 2) {
            const bool last = (t == nt - 2);
            const char* a1 = cA + (size_t)(t + 1) * kstepA;
            const char* a2 = last ? nA : cA + (size_t)(t + 2) * kstepA; const char* b2 = last ? nB : cB + (size_t)(t + 2) * kstep;
            const char* a3 = a2 + kstepA; const char* b3 = b2 + kstep;
            if (last && has_next) S.a_ready(nxt);
            if constexpr (SP2) {
            PG8_LDB(B0, 0, 0); PG8_LDB(B1, 0, 1); PG8_SCHED; PG8_LDA(At, 0, 0); PG8_STAGE(PG8_SA(1, 1), a1 + hstep, voffA);
            PG8_WAIT_V(8); PG8_WAIT_L(0); PG8_BAR; PG8_MMA(0, 0, At, B0); PG8_MMA(0, 1, At, B1); PG8_BAR; PG8_SCHED;
            PG8_LDA(At, 0, 1); PG8_STAGE(PG8_SB(0, 0), b2, voffB); PG8_STAGE(PG8_SB(0, 1), b2 + hstep, voffB); PG8_STAGE(PG8_SA(0, 0), a2, voffA);
            PG8_WAIT_V(8); PG8_WAIT_L(0); PG8_BAR; PG8_MMA(1, 0, At, B0); PG8_MMA(1, 1, At, B1); PG8_BAR; PG8_SCHED;
            PG8_LDB(B0, 1, 0); PG8_LDB(B1, 1, 1); PG8_SCHED; PG8_LDA(At, 1, 0); PG8_STAGE(PG8_SA(0, 1), a2 + hstep, voffA);
            PG8_WAIT_V(8); PG8_WAIT_L(0); PG8_BAR; PG8_MMA(0, 0, At, B0); PG8_MMA(0, 1, At, B1); PG8_BAR; PG8_SCHED;
            PG8_LDA(At, 1, 1); PG8_STAGE(PG8_SB(1, 0), b3, voffB); PG8_STAGE(PG8_SB(1, 1), b3 + hstep, voffB); PG8_STAGE(PG8_SA(1, 0), a3, voffA);
            PG8_WAIT_V(8); PG8_WAIT_L(0); PG8_BAR; PG8_MMA(1, 0, At, B0); PG8_MMA(1, 1, At, B1); PG8_BAR; PG8_SCHED;
            } else {
            PG8_LDB(B0, 0, 0); PG8_SCHED; PG8_LDA(At, 0, 0); PG8_STAGE(PG8_SA(1, 1), a1 + hstep, voffA);
            PG8_WAIT_L(8); PG8_BAR; PG8_WAIT_L(0); PG8_MMA(0, 0, At, B0); PG8_BAR; PG8_SCHED;
            PG8_LDB(B1, 0, 1); PG8_STAGE(PG8_SB(0, 0), b2, voffB);
            PG8_BAR; PG8_WAIT_L(0); PG8_MMA(0, 1, At, B1); PG8_BAR;
            PG8_LDA(At, 0, 1); PG8_STAGE(PG8_SA(0, 0), a2, voffA);
            PG8_BAR; PG8_WAIT_L(0); PG8_MMA(1, 0, At, B0); PG8_BAR; PG8_SCHED;
            PG8_STAGE(PG8_SB(0, 1), b2 + hstep, voffB);
            PG8_WAIT_V(6); PG8_BAR; PG8_MMA(1, 1, At, B1); PG8_BAR;
            PG8_LDB(B0, 1, 0); PG8_SCHED; PG8_LDA(At, 1, 0); PG8_STAGE(PG8_SA(0, 1), a2 + hstep, voffA);
            PG8_WAIT_L(8); PG8_BAR; PG8_WAIT_L(0); PG8_MMA(0, 0, At, B0); PG8_BAR; PG8_SCHED;
            PG8_LDB(B1, 1, 1); PG8_STAGE(PG8_SB(1, 0), b3, voffB);
            PG8_BAR; PG8_WAIT_L(0); PG8_MMA(0, 1, At, B1); PG8_BAR;
            PG8_LDA(At, 1, 1); PG8_STAGE(PG8_SA(1, 0), a3, voffA);
            PG8_BAR; PG8_WAIT_L(0); PG8_MMA(1, 0, At, B0); PG8_BAR; PG8_SCHED;
            PG8_STAGE(PG8_SB(1, 1), b3 + hstep, voffB);
            PG8_WAIT_V(6); PG8_BAR; PG8_MMA(1, 1, At, B1); PG8_BAR;
            }
        }
        if constexpr (ALIGN_EPI) { if (wr == 0) PG8_BAR; }
        if constexpr (!Epi::AFTER_DRAIN) { const int le_ = hw_lane(); E(acc, cur, wr, wc, le_ & 15, le_ >> 4); S.done(cur); }
        if (!has_next) break;
#pragma unroll
        for (int a = 0; a < 2; ++a)
#pragma unroll
            for (int b = 0; b < 2; ++b)
#pragma unroll
                for (int m = 0; m < 4; ++m)
#pragma unroll
                    for (int n = 0; n < 2; ++n) acc[a][b][m][n] = (f32x4){0.f, 0.f, 0.f, 0.f};
        cur = nxt; cA = nA; cB = nB; ++ui;
        if constexpr (ALIGN_EPI) { if (wr == 1) PG8_BAR; }
    }
    PG8_WAIT_V(0);
    if constexpr (!ALIGN_EPI) { if (wr == 0) PG8_BAR; }
    PG8_BAR;
    if constexpr (Epi::AFTER_DRAIN) { E.fused(acc, cur, wr, wc, fr, fq, lds, wid, lane); S.done(cur); }
#undef PG8_SA
#undef PG8_SB
#undef PG8_STAGE
#undef PG8_LDA
#undef PG8_LDB
#undef PG8_MMA
#undef PG8_WAIT_V
#undef PG8_WAIT_L
#undef PG8_BAR
#undef PG8_SCHED
}
}
namespace att {
#define ALAS __attribute__((address_space(3)))
typedef unsigned short bf16_t;
typedef short bf16x8 __attribute__((ext_vector_type(8)));
typedef short s16x4 __attribute__((ext_vector_type(4)));
typedef float f32x16 __attribute__((ext_vector_type(16)));
typedef float f32x4 __attribute__((ext_vector_type(4)));
typedef unsigned u32x4 __attribute__((ext_vector_type(4)));
constexpr int SEQ = 4096, NH = 16, QKD = 192, VD = 128, QPITCH = NH * QKD  , KVPITCH = NH * 256  , OPITCH = 4096;
constexpr int SHM_V = 64 * 256, SHM_K = 64 * 384;
constexpr int OFF_V = 0, OFF_K = 3 * SHM_V, OFF_WS = 3 * SHM_V + 3 * SHM_K, LDS_BYTES = OFF_WS + 8 * 64 * 4;
#define KSWZ(row, colB) ((row) * 384 + ((colB) ^ ((((row) >> 1) & 7) << 4)))
#define SBAR() __builtin_amdgcn_sched_barrier(0)
__device__ __forceinline__ int v_st(int k, int c) { const int kk = (k & ~0xC) | ((k & 4) << 1) | ((k & 8) >> 1); return ((kk >> 3) * 4 + (c >> 5)) * 512 + ((kk & 7) * 32 + (c & 31)) * 2; }
__device__ __forceinline__ int v_rd_base(int lane) { return ((lane & 3) << 3) | (((lane >> 2) & 3) << 6) | (((lane >> 4) & 1) << 5) | (((lane >> 5) & 1) << 8); }
constexpr int v_rd_off(int d0, int ks, int half) { return d0 * 512 + ks * 4096 + half * 2048; }
__device__ __forceinline__ int crow(int r, int hi) { return (r & 3) + 8 * (r >> 2) + 4 * hi; }
__device__ __forceinline__ unsigned cvtpk(float lo, float hi) { unsigned r; asm volatile("s_nop 0\n\tv_cvt_pk_bf16_f32 %0, %1, %2" : "=v"(r) : "v"(lo), "v"(hi)); return r; }
__device__ __forceinline__ float bflo(unsigned w) { return __uint_as_float(w << 16); }
__device__ __forceinline__ float bfhi(unsigned w) { return __uint_as_float(w & 0xffff0000u); }

__device__ __forceinline__ void qkt(f32x16& p0, f32x16& p1, ALAS const char* Kt, int r32, int hi, const bf16x8* qr) {
    p0 = f32x16{}; p1 = f32x16{};
    ALAS const char* kb[4];
#pragma unroll
    for (int dd = 0; dd < 4; ++dd) kb[dd] = Kt + KSWZ(r32, (dd * 16 + hi * 8) * 2);
    bf16x8 kf[2][4];
#define KLD(bi_, sl_) do { _Pragma("unroll") for (int e_ = 0; e_ < 2; ++e_) { const int d0_ = 2 * (bi_) + e_; ALAS const char* a_ = kb[d0_ & 3] + (d0_ >> 2) * 128; \
        kf[sl_][2 * e_] = *(ALAS const bf16x8*)a_; kf[sl_][2 * e_ + 1] = *(ALAS const bf16x8*)(a_ + 32 * 384); } } while (0)
    KLD(0, 0);
#pragma unroll
    for (int bi = 0; bi < 6; ++bi) {
        if (bi < 5) KLD(bi + 1, (bi + 1) & 1);
        SBAR(); __builtin_amdgcn_s_setprio(1);
#pragma unroll
        for (int e = 0; e < 2; ++e) { const int d0 = 2 * bi + e;
            p0 = __builtin_amdgcn_mfma_f32_32x32x16_bf16(kf[bi & 1][2 * e], qr[d0], p0, 0, 0, 0);
            p1 = __builtin_amdgcn_mfma_f32_32x32x16_bf16(kf[bi & 1][2 * e + 1], qr[d0], p1, 0, 0, 0); }
        __builtin_amdgcn_s_setprio(0); SBAR();
    }
#undef KLD
}
__device__ __forceinline__ void pv_tile(f32x16* o, int vb, bf16x8 pa0, bf16x8 pa1, bf16x8 pa2, bf16x8 pa3) {
#define TRRD(dst, off) asm volatile("ds_read_b64_tr_b16 %0, %1 offset:%2" : "=&v"(dst) : "v"(vb), "i"(off) : "memory")
#define PV_D0(d0) do { s16x4 l0, l1, l2, l3, h0, h1, h2, h3; constexpr int b_ = v_rd_off(d0, 0, 0); \
        TRRD(l0, b_); TRRD(h0, b_ + 2048); TRRD(l1, b_ + 4096); TRRD(h1, b_ + 6144); TRRD(l2, b_ + 8192); TRRD(h2, b_ + 10240); TRRD(l3, b_ + 12288); TRRD(h3, b_ + 14336); \
        asm volatile("s_waitcnt lgkmcnt(0)" ::: "memory"); SBAR(); __builtin_amdgcn_s_setprio(1); \
        o[d0] = __builtin_amdgcn_mfma_f32_32x32x16_bf16(pa0, (bf16x8){l0[0], l0[1], l0[2], l0[3], h0[0], h0[1], h0[2], h0[3]}, o[d0], 0, 0, 0); \
        o[d0] = __builtin_amdgcn_mfma_f32_32x32x16_bf16(pa1, (bf16x8){l1[0], l1[1], l1[2], l1[3], h1[0], h1[1], h1[2], h1[3]}, o[d0], 0, 0, 0); \
        o[d0] = __builtin_amdgcn_mfma_f32_32x32x16_bf16(pa2, (bf16x8){l2[0], l2[1], l2[2], l2[3], h2[0], h2[1], h2[2], h2[3]}, o[d0], 0, 0, 0); \
        o[d0] = __builtin_amdgcn_mfma_f32_32x32x16_bf16(pa3, (bf16x8){l3[0], l3[1], l3[2], l3[3], h3[0], h3[1], h3[2], h3[3]}, o[d0], 0, 0, 0); __builtin_amdgcn_s_setprio(0); } while (0)
    PV_D0(0); PV_D0(1); PV_D0(2); PV_D0(3);
#undef PV_D0
#undef TRRD
}
struct Tensors { const bf16_t* Q; const bf16_t* KV; const bf16_t* KR; const float* RC; const float* RS; bf16_t* O; };
__device__ __forceinline__ void unit(const Tensors& T, int bh, int qb, ALAS char* lds, int wid_in) {
    const int wid = __builtin_amdgcn_readfirstlane(wid_in), lane = hw_lane(), tid = wid * 64 + lane, r32 = lane & 31, hi = lane >> 5;
    const int b = bh >> 4, h = bh & 15; const size_t rowbase = (size_t)b * SEQ; const int q0 = qb * 256, NT = 4 * (qb + 1);
    ALAS char* V_lds = lds + OFF_V; ALAS char* K_lds = lds + OFF_K;
    ALAS float* ws = (ALAS float*)(lds + OFF_WS) + wid * 64; ALAS float* li_l = ws; ALAS float* al_l = ws + 32;
    const size_t qrow = rowbase + q0 + wid * 32 + r32;
    const bf16_t* Qw = T.Q + qrow * QPITCH + h * QKD + hi * 8;
    bf16x8 qr[12];
#pragma unroll
    for (int d0 = 0; d0 < 12; ++d0) qr[d0] = *(const bf16x8*)(Qw + d0 * 16);
#pragma unroll
    for (int p = 0; p < 2; ++p) { const float* cp = T.RC + qrow * 32 + 16 * p + 8 * hi; const float* sp = T.RS + qrow * 32 + 16 * p + 8 * hi;
        const f32x4 c0 = *(const f32x4*)cp, c1 = *(const f32x4*)(cp + 4), s0 = *(const f32x4*)sp, s1 = *(const f32x4*)(sp + 4);
        const u32x4 a = __builtin_bit_cast(u32x4, qr[8 + p]), bb = __builtin_bit_cast(u32x4, qr[10 + p]); u32x4 na, nb;
#pragma unroll
        for (int w = 0; w < 4; ++w) { const float cl = w < 2 ? c0[2 * w] : c1[2 * w - 4], ch = w < 2 ? c0[2 * w + 1] : c1[2 * w - 3], sl = w < 2 ? s0[2 * w] : s1[2 * w - 4], sh = w < 2 ? s0[2 * w + 1] : s1[2 * w - 3];
            const float x1l = bflo(a[w]), x1h = bfhi(a[w]), x2l = bflo(bb[w]), x2h = bfhi(bb[w]);
            na[w] = cvtpk(x1l * cl - x2l * sl, x1h * ch - x2h * sh); nb[w] = cvtpk(x2l * cl + x1l * sl, x2h * ch + x1h * sh); }
        qr[8 + p] = __builtin_bit_cast(bf16x8, na); qr[10 + p] = __builtin_bit_cast(bf16x8, nb); }
    const char* KVb = (const char*)T.KV; const char* KRb = (const char*)T.KR;
    unsigned koff[3]; unsigned krope = 0u;
#pragma unroll
    for (int i = 0; i < 3; ++i) { const int ci = (wid + 8 * i) * 64 + lane, row = ci / 24, sl = ci - row * 24, c = ((sl & 7) ^ ((row >> 1) & 7)) | (sl & 24);
        const bool rp = c >= 16; if (rp) krope |= (1u << i);
        koff[i] = rp ? (unsigned)(((rowbase + row) * 64 + (c - 16) * 8) * 2) : (unsigned)(((rowbase + row) * KVPITCH + h * 256 + c * 8) * 2); }
    unsigned voff[2];
#pragma unroll
    for (int i = 0; i < 2; ++i) { const int ob = (wid + 8 * i) * 1024 + lane * 16, st = ob >> 9, kk = (st >> 2) * 8 + ((ob & 511) >> 6), c = (st & 3) * 32 + ((ob & 63) >> 1), k = (kk & ~0xC) | ((kk & 4) << 1) | ((kk & 8) >> 1);
        voff[i] = (unsigned)(((rowbase + k) * KVPITCH + h * 256 + 128 + c) * 2); }
    const int vb0 = (int)(unsigned)(uintptr_t)V_lds + v_rd_base(lane);
#define SDMA(t_, ko_, vo_) do { \
        _Pragma("unroll") for (int i_ = 0; i_ < 3; ++i_) { const bool rp_ = (krope >> i_) & 1u; const char* src_ = (rp_ ? KRb : KVb) + (koff[i_] + (unsigned)(t_) * (rp_ ? 8192u : 64u * KVPITCH * 2u)); \
            __builtin_amdgcn_global_load_lds((const unsigned*)src_, (ALAS unsigned*)(K_lds + (ko_) + (wid + 8 * i_) * 1024), 16, 0, 0); } \
        _Pragma("unroll") for (int i_ = 0; i_ < 2; ++i_) { const char* src_ = KVb + (voff[i_] + (unsigned)(t_) * (64u * KVPITCH * 2u)); \
            __builtin_amdgcn_global_load_lds((const unsigned*)src_, (ALAS unsigned*)(V_lds + (vo_) + (wid + 8 * i_) * 1024), 16, 0, 0); } } while (0)
    float m_reg = -1e30f, l_reg = 0.f; f32x16 o[4] = {};
    const int qlo = q0 + wid * 32, qpos = qlo + r32;
    SDMA(0, 0, 0); SDMA(1, SHM_K, SHM_V);
    asm volatile("s_waitcnt vmcnt(5)" ::: "memory"); __builtin_amdgcn_s_barrier(); asm volatile("" ::: "memory");
    f32x16 p0, p1; bf16x8 pa0, pa1, pa2, pa3;
#define PK4(P, B_, OUT) do { unsigned a0 = cvtpk(P[B_ + 0], P[B_ + 1]), a1 = cvtpk(P[B_ + 2], P[B_ + 3]); unsigned b0 = cvtpk(P[B_ + 4], P[B_ + 5]), b1 = cvtpk(P[B_ + 6], P[B_ + 7]); \
        auto r0 = __builtin_amdgcn_permlane32_swap(a0, b0, false, false); auto r1 = __builtin_amdgcn_permlane32_swap(a1, b1, false, false); \
        u32x4 w = {r0[0], r1[0], r0[1], r1[1]}; OUT = __builtin_bit_cast(bf16x8, w); } while (0)
#define QK_SM(tt_, ko_) do { SBAR(); qkt(p0, p1, K_lds + (ko_), r32, hi, qr); \
        { const int kb_ = (tt_) * 64; if (kb_ + 63 > qlo) { const int dq = qpos - kb_ - 4 * hi; const float NEG = -__builtin_inff(); \
            _Pragma("unroll") for (int r = 0; r < 16; ++r) { const int c = (r & 3) + 8 * (r >> 2); if (c > dq) p0[r] = NEG; if (c + 32 > dq) p1[r] = NEG; } } } \
        float pmax = p0[0]; _Pragma("unroll") for (int r = 1; r < 16; ++r) pmax = fmaxf(pmax, p0[r]); _Pragma("unroll") for (int r = 0; r < 16; ++r) pmax = fmaxf(pmax, p1[r]); \
        { auto rr_ = __builtin_amdgcn_permlane32_swap(__float_as_uint(pmax), __float_as_uint(pmax), false, false); pmax = fmaxf(__uint_as_float(rr_[0]), __uint_as_float(rr_[1])); } \
        float alpha = 1.f; \
        if (!__all(pmax - m_reg <= 8.0f)) { const float mn = fmaxf(m_reg, pmax); alpha = __builtin_amdgcn_exp2f(m_reg - mn); m_reg = mn;     \
            if (hi == 0) al_l[r32] = alpha; asm volatile("s_waitcnt lgkmcnt(0)" ::: "memory"); \
            _Pragma("unroll") for (int d_ = 0; d_ < 4; ++d_) _Pragma("unroll") for (int r = 0; r < 16; ++r) o[d_][r] *= al_l[crow(r, hi)]; } \
        _Pragma("unroll") for (int r = 0; r < 16; ++r) { p0[r] = __builtin_amdgcn_exp2f(p0[r] - m_reg); p1[r] = __builtin_amdgcn_exp2f(p1[r] - m_reg); } \
        float ps = 0.f; _Pragma("unroll") for (int r = 0; r < 16; ++r) ps += p0[r]; _Pragma("unroll") for (int r = 0; r < 16; ++r) ps += p1[r]; \
        { auto rr_ = __builtin_amdgcn_permlane32_swap(__float_as_uint(ps), __float_as_uint(ps), false, false); ps = __uint_as_float(rr_[0]) + __uint_as_float(rr_[1]); } \
        l_reg = l_reg * alpha + ps; \
        PK4(p0, 0, pa0); PK4(p0, 8, pa1); PK4(p1, 0, pa2); PK4(p1, 8, pa3); SBAR(); } while (0)
    int ko = 0, vo = 0, kn2 = 2 * SHM_K, vn2 = 2 * SHM_V;
    for (int t = 0; t < NT; ++t) { const bool more2 = t + 2 < NT;
        if (more2) SDMA(t + 2, kn2, vn2);
        if (t * 64 <= qlo + 31) {
            QK_SM(t, ko);
            pv_tile(o, vb0 + vo, pa0, pa1, pa2, pa3); }
        asm volatile("s_waitcnt lgkmcnt(0)" ::: "memory");
        if (more2) asm volatile("s_waitcnt vmcnt(5)" ::: "memory"); else asm volatile("s_waitcnt vmcnt(0)" ::: "memory");
        __builtin_amdgcn_s_barrier(); asm volatile("" ::: "memory");
        kn2 = ko; vn2 = vo;
        ko = (ko == 2 * SHM_K) ? 0 : ko + SHM_K; vo = (vo == 2 * SHM_V) ? 0 : vo + SHM_V; }
#undef PK4
#undef QK_SM
#undef SDMA
    if (hi == 0) li_l[r32] = l_reg; asm volatile("s_waitcnt lgkmcnt(0)" ::: "memory");
    float rli[16];
#pragma unroll
    for (int r = 0; r < 16; ++r) rli[r] = __builtin_amdgcn_rcpf(li_l[crow(r, hi)]);
    bf16_t* Ow = T.O + (rowbase + q0 + wid * 32) * OPITCH + h * VD;
    ALAS char* stg = K_lds + wid * (32 * 272);
#pragma unroll
    for (int r = 0; r < 16; ++r) { const int orow = crow(r, hi);
#pragma unroll
        for (int d0 = 0; d0 < 4; ++d0) { const float v = o[d0][r] * rli[r]; const float vn = __int_as_float(__builtin_amdgcn_mov_dpp(__float_as_int(v), 0xB1  , 0xF, 0xF, true));
            if ((r32 & 1) == 0) *(ALAS unsigned*)(stg + orow * 272 + (d0 * 32 + r32) * 2) = cvtpk(v, vn); } }
    asm volatile("s_waitcnt lgkmcnt(0)" ::: "memory");
#pragma unroll
    for (int j = 0; j < 8; ++j) { const int idx = j * 64 + lane, row = idx >> 4, ch = idx & 15; const u32x4 w = *(ALAS const u32x4*)(stg + row * 272 + ch * 16);
        *(u32x4*)(Ow + (size_t)row * OPITCH + ch * 8) = w; }
    __syncthreads();
}
#undef SBAR
}
namespace hg {
#define HLAS __attribute__((address_space(3)))
#define HGAS __attribute__((address_space(1)))
#define HG_SYNC() do { asm volatile("s_waitcnt lgkmcnt(0)" ::: "memory"); __builtin_amdgcn_s_barrier(); asm volatile("" ::: "memory"); } while (0)
typedef unsigned short bf16_t;
typedef short bf16x8 __attribute__((ext_vector_type(8)));
typedef short s16x4 __attribute__((ext_vector_type(4)));
typedef float f32x16 __attribute__((ext_vector_type(16)));
typedef float f32x4 __attribute__((ext_vector_type(4)));
typedef unsigned u32x4 __attribute__((ext_vector_type(4)));
typedef unsigned u32x2 __attribute__((ext_vector_type(2)));
constexpr int SEQ = 4096, HGD = 2048, NCH = 64  , NUNIT = 4 * 16 * NCH;
__device__ __forceinline__ unsigned cvtpk(float lo, float hi) { unsigned r; asm volatile("s_nop 0\n\tv_cvt_pk_bf16_f32 %0, %1, %2" : "=v"(r) : "v"(lo), "v"(hi)); return r; }
__device__ __forceinline__ float bflo(unsigned w) { return __uint_as_float(w << 16); }
__device__ __forceinline__ float bfhi(unsigned w) { return __uint_as_float(w & 0xffff0000u); }

constexpr int P1_V = 0, P1_K = 16384, P1_GT = 32768;
struct P1In { u32x2 kw[4]; u32x4 v0, v1; };
__device__ __forceinline__ void pass1_load(P1In& I, const bf16_t* KF, const bf16_t* VH, int unit, int tid) {
    const int bh = unit >> 6, c = unit & 63, b = bh >> 4, h = bh & 15; const size_t row0 = (size_t)b * SEQ + 64 * c;
    const int cq = tid & 31, tg = tid >> 5;
#pragma unroll
    for (int i = 0; i < 4; ++i) I.kw[i] = *(const HGAS u32x2*)(KF + (row0 + 4 * tg + i) * HGD + h * 128 + 4 * cq);
    const int sr = tid >> 4, sc = tid & 15; const bf16_t* vp = VH + (row0 + sr) * HGD + h * 128 + sc * 8;
    I.v0 = *(const HGAS u32x4*)vp; I.v1 = *(const HGAS u32x4*)(vp + 32 * HGD);
}
__device__ __forceinline__ void pass1_compute(const P1In& I, bf16_t* UT, float* DD, int unit, HLAS char* lds, int wid, int lane) {
    const int tid = wid * 64 + lane;
    const int cq = tid & 31, tg = tid >> 5;
    f32x4 f[4];
#pragma unroll
    for (int i = 0; i < 4; ++i) f[i] = (f32x4){1.f - bflo(I.kw[i].x), 1.f - bfhi(I.kw[i].x), 1.f - bflo(I.kw[i].y), 1.f - bfhi(I.kw[i].y)};
    { const int sr = tid >> 4, sc = tid & 15;
      *(HLAS u32x4*)(lds + P1_V + att::v_st(sr, sc * 8)) = I.v0; *(HLAS u32x4*)(lds + P1_V + att::v_st(32 + sr, sc * 8)) = I.v1; }
    f32x4 suf[4]; suf[3] = (f32x4){1.f, 1.f, 1.f, 1.f}; suf[2] = f[3]; suf[1] = f[3] * f[2]; suf[0] = suf[1] * f[1];
    const f32x4 gt = suf[0] * f[0];
    HLAS f32x4* GT = (HLAS f32x4*)(lds + P1_GT);
    GT[tg * 32 + cq] = gt;
    HG_SYNC();
    f32x4 lp = (f32x4){1.f, 1.f, 1.f, 1.f};
#pragma unroll
    for (int i = 1; i < 16; ++i) { const f32x4 g = GT[i * 32 + cq]; if (i > tg) lp = lp * g; }
    if (tg == 0) *(HGAS f32x4*)(DD + (size_t)unit * 128 + 4 * cq) = lp * gt;
#pragma unroll
    for (int i = 0; i < 4; ++i) { const f32x4 kt = ((f32x4){1.f, 1.f, 1.f, 1.f} - f[i]) * suf[i] * lp;
        u32x2 w; w.x = cvtpk(kt.x, kt.y); w.y = cvtpk(kt.z, kt.w); *(HLAS u32x2*)(lds + P1_K + att::v_st(4 * tg + i, 4 * cq)) = w; }
    HG_SYNC();
    const int vt = wid >> 1, kt0 = 2 * (wid & 1);
    const int vbV = (int)(unsigned)(uintptr_t)(lds + P1_V) + att::v_rd_base(lane), vbK = (int)(unsigned)(uintptr_t)(lds + P1_K) + att::v_rd_base(lane);
    f32x16 acc0 = {}, acc1 = {};
#define HTR(dst, base, off) asm volatile("ds_read_b64_tr_b16 %0, %1 offset:%2" : "=&v"(dst) : "v"(base), "i"(off) : "memory")
#pragma unroll
    for (int ks = 0; ks < 4; ++ks) { s16x4 al, ah, b0l, b0h, b1l, b1h;
        const int oa = vt * 512 + ks * 4096, ob = kt0 * 512 + ks * 4096;
        asm volatile("ds_read_b64_tr_b16 %0, %1" : "=&v"(al) : "v"(vbV + oa) : "memory"); asm volatile("ds_read_b64_tr_b16 %0, %1" : "=&v"(ah) : "v"(vbV + oa + 2048) : "memory");
        asm volatile("ds_read_b64_tr_b16 %0, %1" : "=&v"(b0l) : "v"(vbK + ob) : "memory"); asm volatile("ds_read_b64_tr_b16 %0, %1" : "=&v"(b0h) : "v"(vbK + ob + 2048) : "memory");
        asm volatile("ds_read_b64_tr_b16 %0, %1" : "=&v"(b1l) : "v"(vbK + ob + 512) : "memory"); asm volatile("ds_read_b64_tr_b16 %0, %1" : "=&v"(b1h) : "v"(vbK + ob + 512 + 2048) : "memory");
        asm volatile("s_waitcnt lgkmcnt(0)" ::: "memory"); __builtin_amdgcn_sched_barrier(0);
        const bf16x8 a = {al[0], al[1], al[2], al[3], ah[0], ah[1], ah[2], ah[3]}, b0 = {b0l[0], b0l[1], b0l[2], b0l[3], b0h[0], b0h[1], b0h[2], b0h[3]}, b1 = {b1l[0], b1l[1], b1l[2], b1l[3], b1h[0], b1h[1], b1h[2], b1h[3]};
        acc0 = __builtin_amdgcn_mfma_f32_32x32x16_bf16(a, b0, acc0, 0, 0, 0); acc1 = __builtin_amdgcn_mfma_f32_32x32x16_bf16(a, b1, acc1, 0, 0, 0); }
#undef HTR
    { const int r32 = lane & 31, hi = lane >> 5; HLAS char* stg = lds + 40960 + wid * (32 * 144);
#pragma unroll
      for (int r = 0; r < 16; ++r) { const int vrow = att::crow(r, hi); const float a0 = acc0[r], a1 = acc1[r];
          const float n0 = __int_as_float(__builtin_amdgcn_mov_dpp(__float_as_int(a0), 0xB1, 0xF, 0xF, true)), n1 = __int_as_float(__builtin_amdgcn_mov_dpp(__float_as_int(a1), 0xB1, 0xF, 0xF, true));
          if ((r32 & 1) == 0) { *(HLAS unsigned*)(stg + vrow * 144 + r32 * 2) = cvtpk(a0, n0); *(HLAS unsigned*)(stg + vrow * 144 + (32 + r32) * 2) = cvtpk(a1, n1); } }
      asm volatile("s_waitcnt lgkmcnt(0)" ::: "memory");
      bf16_t* up = UT + (size_t)unit * 16384 + (size_t)(32 * vt) * 128 + 32 * kt0;
#pragma unroll
      for (int j = 0; j < 4; ++j) { const int idx = j * 64 + lane, row = idx >> 3, ch = idx & 7; const u32x4 w = *(HLAS const u32x4*)(stg + row * 144 + ch * 16);
          *(HGAS u32x4*)(up + (size_t)row * 128 + ch * 8) = w; } }
    HG_SYNC();
}
__device__ __forceinline__ void pass1_all(const bf16_t* KF, const bf16_t* VH, bf16_t* UT, float* DD, int u0, int ustride, HLAS char* lds, int wid_in) {
    const int wid = __builtin_amdgcn_readfirstlane(wid_in), lane = hw_lane(), tid = wid * 64 + lane;
    P1In A, B;
    int u = u0;
    if (u < NUNIT) pass1_load(A, KF, VH, u, tid);
    while (u < NUNIT) {
        const int u2 = u + ustride, u3 = u2 + ustride;
        if (u2 < NUNIT) pass1_load(B, KF, VH, u2, tid);
        pass1_compute(A, UT, DD, u, lds, wid, lane);
        if (u2 >= NUNIT) break;
        if (u3 < NUNIT) pass1_load(A, KF, VH, u3, tid);
        pass1_compute(B, UT, DD, u2, lds, wid, lane);
        u = u3;
    }
}

__device__ __forceinline__ void pass2_scan(bf16_t* UT, const float* DD, int gt, int NGT) {
    for (int idx = gt; idx < 64 * 2048; idx += NGT) {
        const int bh = idx >> 11, rem = idx & 2047, v = rem >> 4, ko = rem & 15;
        bf16_t* up = UT + (size_t)bh * NCH * 16384 + (size_t)v * 128 + 8 * ko; const float* dp = DD + (size_t)bh * NCH * 128 + 8 * ko;
        float S[8] = {0.f, 0.f, 0.f, 0.f, 0.f, 0.f, 0.f, 0.f};
        for (int c0 = 0; c0 < NCH; c0 += 8) {
            u32x4 u[8]; f32x4 d0[8], d1[8];
#pragma unroll
            for (int i = 0; i < 8; ++i) { u[i] = *(const HGAS u32x4*)(up + (size_t)(c0 + i) * 16384); d0[i] = *(const HGAS f32x4*)(dp + (size_t)(c0 + i) * 128); d1[i] = *(const HGAS f32x4*)(dp + (size_t)(c0 + i) * 128 + 4); }
#pragma unroll
            for (int i = 0; i < 8; ++i) {
                u32x4 o; o.x = cvtpk(S[0], S[1]); o.y = cvtpk(S[2], S[3]); o.z = cvtpk(S[4], S[5]); o.w = cvtpk(S[6], S[7]);
                *(HGAS u32x4*)(up + (size_t)(c0 + i) * 16384) = o;
                S[0] = d0[i].x * S[0] + bflo(u[i].x); S[1] = d0[i].y * S[1] + bfhi(u[i].x); S[2] = d0[i].z * S[2] + bflo(u[i].y); S[3] = d0[i].w * S[3] + bfhi(u[i].y);
                S[4] = d1[i].x * S[4] + bflo(u[i].z); S[5] = d1[i].y * S[5] + bfhi(u[i].z); S[6] = d1[i].z * S[6] + bflo(u[i].w); S[7] = d1[i].w * S[7] + bfhi(u[i].w); }
        }
    }
}

constexpr int RSQ = 272, RSV = 288;
constexpr int P3_QH = 0, P3_QT = 64 * RSQ, P3_W = 128 * RSQ, P3_V = 288 * RSQ, P3_GT = P3_V + 64 * RSV, P3_SS = P3_GT + 8192, P3_END = P3_SS + 512;
static_assert(P3_END <= 131072, "pass-3 LDS");
constexpr int P3_S0 = P3_END, P3_S1 = 131072 + 1024;
static_assert(P3_S0 + 16384 <= 131072, "pass-3 state stage");
__device__ __forceinline__ void pass3_sdma(const bf16_t* ST, int unit, HLAS char* lds, int wid, int lane) {
    const char* sb = (const char*)ST + (size_t)unit * 32768;
#pragma unroll
    for (int i = 0; i < 4; ++i) { const int p = wid + 8 * i, r = 4 * p + (lane >> 4), c = (lane & 15) ^ (r & 15);
        __builtin_amdgcn_global_load_lds((const unsigned*)(sb + r * 256 + c * 16), (HLAS unsigned*)(lds + (i < 2 ? P3_S0 + 1024 * p : P3_S1 + 1024 * (p - 16))), 16, 0, 0); }
    __builtin_amdgcn_sched_barrier(0);
}
__device__ __forceinline__ int wbase(int J) { return J == 0 ? 0 : J == 1 ? 16 : J == 2 ? 48 : 96; }
struct P3In { u32x2 kw[4]; u32x2 qw[4]; u32x4 v0, v1; };
__device__ __forceinline__ void pass3_load(P3In& I, const bf16_t* KF, const bf16_t* QH, const bf16_t* VH, int unit, int tid) {
    const int bh = unit >> 6, c = unit & 63, b = bh >> 4, h = bh & 15; const size_t row0 = (size_t)b * SEQ + 64 * c;
    const int cq = tid & 31, tg = tid >> 5;
#pragma unroll
    for (int i = 0; i < 4; ++i) { I.kw[i] = *(const HGAS u32x2*)(KF + (row0 + 4 * tg + i) * HGD + h * 128 + 4 * cq); I.qw[i] = *(const HGAS u32x2*)(QH + (row0 + 4 * tg + i) * HGD + h * 128 + 4 * cq); }
    const int sr = tid >> 4, sc = tid & 15; const bf16_t* vp = VH + (row0 + sr) * HGD + h * 128 + sc * 8;
    I.v0 = *(const HGAS u32x4*)vp; I.v1 = *(const HGAS u32x4*)(vp + 32 * HGD);
}
__device__ __forceinline__ void pass3_compute(const P3In& I, const bf16_t* GH, const bf16_t* ST, const float* gout, bf16_t* MIX, int unit, int next_unit  , bool prefetched  , HLAS char* lds, int wid, int lane) {
    const int tid = wid * 64 + lane;
    const int bh = unit >> 6, c = unit & 63, b = bh >> 4, h = bh & 15; const size_t row0 = (size_t)b * SEQ + 64 * c;
    const int cq = tid & 31, tg = tid >> 5, j = tg >> 2, pos = tg & 3;
    const int J = wid >> 1, vh = wid & 1, tl = lane & 15, g = lane >> 4;
    const f32x4 one = (f32x4){1.f, 1.f, 1.f, 1.f};
    bf16x8 sf[4][4]; u32x2 gg[4];
    const size_t orow = row0 + 16 * J + tl;
    { const int sr = tid >> 4, sc = tid & 15; *(HLAS u32x4*)(lds + P3_V + sr * RSV + sc * 16) = I.v0; *(HLAS u32x4*)(lds + P3_V + (32 + sr) * RSV + sc * 16) = I.v1; }
    f32x4 kq[4], f[4];
#pragma unroll
    for (int i = 0; i < 4; ++i) { kq[i] = (f32x4){bflo(I.kw[i].x), bfhi(I.kw[i].x), bflo(I.kw[i].y), bfhi(I.kw[i].y)}; f[i] = one - kq[i]; }
    f32x4 pre[4], suf[4]; pre[0] = f[0]; pre[1] = f[0] * f[1]; pre[2] = pre[1] * f[2]; pre[3] = pre[2] * f[3];
    suf[3] = one; suf[2] = f[3]; suf[1] = f[3] * f[2]; suf[0] = suf[1] * f[1];
    HLAS f32x4* GT = (HLAS f32x4*)(lds + P3_GT);
    GT[tg * 32 + cq] = pre[3];
    HG_SYNC();
    f32x4 T[4], E = one, E2 = one;
#pragma unroll
    for (int qd = 0; qd < 4; ++qd) { f32x4 t = one;
#pragma unroll
        for (int m = 0; m < 4; ++m) { const f32x4 gq = GT[(4 * qd + m) * 32 + cq]; t = t * gq; if (qd == j && m < pos) E = E * gq; if (qd == j && m > pos) E2 = E2 * gq; }
        T[qd] = t; }
    f32x4 H = one;
#pragma unroll
    for (int qd = 0; qd < 3; ++qd) if (qd < j) H = H * T[qd];
    const f32x4 T1 = (j == 0) ? T[1] : (j == 1) ? T[2] : T[3];
    const f32x4 T2 = (j == 0) ? T[2] : T[3];
#pragma unroll
    for (int i = 0; i < 4; ++i) { const int t = 4 * tg + i;
        const f32x4 p = E * pre[i], q = (f32x4){bflo(I.qw[i].x), bfhi(I.qw[i].x), bflo(I.qw[i].y), bfhi(I.qw[i].y)}, kk = kq[i];
        const f32x4 qh = q * p, qt = qh * H;
        f32x4 w0; w0.x = kk.x * __builtin_amdgcn_rcpf(p.x); w0.y = kk.y * __builtin_amdgcn_rcpf(p.y); w0.z = kk.z * __builtin_amdgcn_rcpf(p.z); w0.w = kk.w * __builtin_amdgcn_rcpf(p.w);
        const f32x4 w1 = kk * suf[i] * E2, w2 = w1 * T1, w3 = w2 * T2;
        u32x2 o; o.x = cvtpk(qh.x, qh.y); o.y = cvtpk(qh.z, qh.w); *(HLAS u32x2*)(lds + P3_QH + t * RSQ + cq * 8) = o;
        o.x = cvtpk(qt.x, qt.y); o.y = cvtpk(qt.z, qt.w); *(HLAS u32x2*)(lds + P3_QT + t * RSQ + cq * 8) = o;
        o.x = cvtpk(w0.x, w0.y); o.y = cvtpk(w0.z, w0.w); *(HLAS u32x2*)(lds + P3_W + (wbase(j) + t) * RSQ + cq * 8) = o;
        if (j < 3) { o.x = cvtpk(w1.x, w1.y); o.y = cvtpk(w1.z, w1.w); *(HLAS u32x2*)(lds + P3_W + (wbase(j + 1) + t) * RSQ + cq * 8) = o; }
        if (j < 2) { o.x = cvtpk(w2.x, w2.y); o.y = cvtpk(w2.z, w2.w); *(HLAS u32x2*)(lds + P3_W + (wbase(j + 2) + t) * RSQ + cq * 8) = o; }
        if (j < 1) { o.x = cvtpk(w3.x, w3.y); o.y = cvtpk(w3.z, w3.w); *(HLAS u32x2*)(lds + P3_W + (wbase(j + 3) + t) * RSQ + cq * 8) = o; } }
    if (prefetched) asm volatile("s_waitcnt vmcnt(10)" ::: "memory"); else asm volatile("s_waitcnt vmcnt(0)" ::: "memory");
    HG_SYNC();
    f32x4 gwv[4];
#pragma unroll
    for (int vt = 0; vt < 4; ++vt) { gg[vt] = *(const HGAS u32x2*)(GH + orow * HGD + h * 128 + 64 * vh + 16 * vt + 4 * g); gwv[vt] = *(const HGAS f32x4*)(gout + h * 128 + 64 * vh + 16 * vt + 4 * g); }
    bf16x8 qf[4];
#pragma unroll
    for (int k4 = 0; k4 < 4; ++k4) qf[k4] = *(const HLAS bf16x8*)(lds + P3_QH + (16 * J + tl) * RSQ + (32 * k4 + 8 * g) * 2);
    f32x4 X[4];
#pragma unroll
    for (int i = 0; i < 4; ++i) { X[i] = (f32x4){0.f, 0.f, 0.f, 0.f};
        if (i <= J) {
#pragma unroll
            for (int k4 = 0; k4 < 4; ++k4) { const bf16x8 wf = *(const HLAS bf16x8*)(lds + P3_W + (wbase(J) + 16 * i + tl) * RSQ + (32 * k4 + 8 * g) * 2);
                X[i] = __builtin_amdgcn_mfma_f32_16x16x32_bf16(wf, qf[k4], X[i], 0, 0, 0); }
            if (i == J) {
#pragma unroll
                for (int r = 0; r < 4; ++r) if (4 * g + r > tl) X[i][r] = 0.f; } } }
    bf16x8 Bf[2];
    { u32x4 w; w.x = cvtpk(X[0][0], X[0][1]); w.y = cvtpk(X[0][2], X[0][3]); w.z = cvtpk(X[1][0], X[1][1]); w.w = cvtpk(X[1][2], X[1][3]); Bf[0] = __builtin_bit_cast(bf16x8, w);
      w.x = cvtpk(X[2][0], X[2][1]); w.y = cvtpk(X[2][2], X[2][3]); w.z = cvtpk(X[3][0], X[3][1]); w.w = cvtpk(X[3][2], X[3][3]); Bf[1] = __builtin_bit_cast(bf16x8, w); }
#pragma unroll
    for (int k4 = 0; k4 < 4; ++k4) qf[k4] = *(const HLAS bf16x8*)(lds + P3_QT + (16 * J + tl) * RSQ + (32 * k4 + 8 * g) * 2);
    { HLAS const char* sbase = lds + (vh ? P3_S1 : P3_S0) + tl * 256;
#pragma unroll
      for (int vt = 0; vt < 4; ++vt)
#pragma unroll
          for (int k4 = 0; k4 < 4; ++k4) sf[vt][k4] = *(const HLAS bf16x8*)(sbase + vt * 4096 + (((4 * k4 + g) ^ tl) & 15) * 16); }
    f32x4 O[4]; float ss = 0.f;
    const int vtr = (int)(unsigned)(uintptr_t)(lds + P3_V) + (4 * g + (tl >> 2)) * RSV + (64 * vh + 4 * (lane & 3)) * 2;
#pragma unroll
    for (int vt = 0; vt < 4; ++vt) { O[vt] = (f32x4){0.f, 0.f, 0.f, 0.f};
#pragma unroll
        for (int k4 = 0; k4 < 4; ++k4) O[vt] = __builtin_amdgcn_mfma_f32_16x16x32_bf16(sf[vt][k4], qf[k4], O[vt], 0, 0, 0);
#pragma unroll
        for (int p = 0; p < 2; ++p) if (2 * p <= J) { s16x4 lo, hi2;
            asm volatile("ds_read_b64_tr_b16 %0, %1" : "=&v"(lo) : "v"(vtr + (32 * p) * RSV + (16 * vt) * 2) : "memory");
            asm volatile("ds_read_b64_tr_b16 %0, %1" : "=&v"(hi2) : "v"(vtr + (32 * p + 16) * RSV + (16 * vt) * 2) : "memory");
            asm volatile("s_waitcnt lgkmcnt(0)" ::: "memory"); __builtin_amdgcn_sched_barrier(0);
            const bf16x8 vf = {lo[0], lo[1], lo[2], lo[3], hi2[0], hi2[1], hi2[2], hi2[3]};
            O[vt] = __builtin_amdgcn_mfma_f32_16x16x32_bf16(vf, Bf[p], O[vt], 0, 0, 0); }
        ss += (O[vt][0] * O[vt][0] + O[vt][1] * O[vt][1]) + (O[vt][2] * O[vt][2] + O[vt][3] * O[vt][3]); }
    ss += __shfl_xor(ss, 16); ss += __shfl_xor(ss, 32);
    HLAS float* SS = (HLAS float*)(lds + P3_SS);
    if (g == 0) SS[vh * 64 + 16 * J + tl] = ss;
    HG_SYNC();
    f32x4 fac[4];
#pragma unroll
    for (int vt = 0; vt < 4; ++vt) fac[vt] = (f32x4){gwv[vt].x * bflo(gg[vt].x), gwv[vt].y * bfhi(gg[vt].x), gwv[vt].z * bflo(gg[vt].y), gwv[vt].w * bfhi(gg[vt].y)};
    asm volatile("" :: "v"(fac[0].x), "v"(fac[0].y), "v"(fac[0].z), "v"(fac[0].w), "v"(fac[1].x), "v"(fac[1].y), "v"(fac[1].z), "v"(fac[1].w), "v"(fac[2].x), "v"(fac[2].y), "v"(fac[2].z), "v"(fac[2].w), "v"(fac[3].x), "v"(fac[3].y), "v"(fac[3].z), "v"(fac[3].w) : "memory");
    __builtin_amdgcn_sched_barrier(0);
    if (next_unit >= 0) pass3_sdma(ST, next_unit, lds, wid, lane);
    const float tot = SS[16 * J + tl] + SS[64 + 16 * J + tl];
    const float rstd = 1.0f / sqrtf(tot * (1.0f / 128.0f) + 1e-6f);
#pragma unroll
    for (int vt = 0; vt < 4; ++vt) { const int v4 = 64 * vh + 16 * vt + 4 * g;
        u32x2 o; o.x = cvtpk(O[vt][0] * rstd * fac[vt].x, O[vt][1] * rstd * fac[vt].y); o.y = cvtpk(O[vt][2] * rstd * fac[vt].z, O[vt][3] * rstd * fac[vt].w);
        *(HGAS u32x2*)(MIX + orow * 4096 + 2048 + h * 128 + v4) = o; }
    HG_SYNC();
}
__device__ __forceinline__ void pass3_all(const bf16_t* KF, const bf16_t* QH, const bf16_t* VH, const bf16_t* GH, const bf16_t* ST, const float* gout, bf16_t* MIX, int u0, int ustride, HLAS char* lds, int wid_in) {
    const int wid = __builtin_amdgcn_readfirstlane(wid_in), lane = hw_lane(), tid = wid * 64 + lane;
    P3In A, B;
    int u = u0;
    if (u < NUNIT) { pass3_sdma(ST, u, lds, wid, lane); pass3_load(A, KF, QH, VH, u, tid); }
    while (u < NUNIT) {
        const int u2 = u + ustride, u3 = u2 + ustride;
        if (u2 < NUNIT) pass3_load(B, KF, QH, VH, u2, tid);
        pass3_compute(A, GH, ST, gout, MIX, u, u2 < NUNIT ? u2 : -1, u2 < NUNIT, lds, wid, lane);
        if (u2 >= NUNIT) break;
        if (u3 < NUNIT) pass3_load(A, KF, QH, VH, u3, tid);
        pass3_compute(B, GH, ST, gout, MIX, u2, u3 < NUNIT ? u3 : -1, u3 < NUNIT, lds, wid, lane);
        u = u3;
    }
}
}

constexpr int NWAVES = 8;
#ifndef MK_ONE_LAUNCH
#define MK_ONE_LAUNCH 1
#endif
constexpr int N_PHASES = 14;
#ifndef PROBE_DUP
#define PROBE_DUP -1
#endif
constexpr int BATCH = 4, SEQ = 4096, DM = 4096, M = BATCH * SEQ, DFF = 16384, PLE = 256;
constexpr int QLORA = 768, KVLORA = 512, HGD = 2048, INW = 9536, INWP = 9728;
constexpr float EPS = 1e-6f;
constexpr float QSCALE = 0.07216878364870322f * 1.4426950408889634f;
constexpr size_t MiB = 1u << 20;
constexpr size_t WS_CTL = 0, CTL_ZERO_BYTES = 64 * 1024;
constexpr size_t WS_RSX = 1 * MiB, WS_RSQ = WS_RSX + 65536, WS_RSKV = WS_RSQ + 65536, WS_RS1 = WS_RSKV + 65536, WS_RS2 = WS_RS1 + 65536, WS_RSE = WS_RS2 + 65536, WS_LB = WS_RSE + 65536;
constexpr size_t WS_RC = 2 * MiB, WS_RSN = 4 * MiB, WS_KRAW = 6 * MiB, WS_KR = 10 * MiB, WS_PB = 12 * MiB;
constexpr size_t WS_WIN = 20 * MiB, WS_WUQ = 96 * MiB, WS_WUKV = 101 * MiB, WS_WO = 105 * MiB, WS_WPG = 137 * MiB, WS_WPLE = 169 * MiB;
constexpr size_t WS_A = 172 * MiB;
constexpr size_t WS_MIX = 940 * MiB;
constexpr size_t WS_B = 300 * MiB;
constexpr size_t WS_C = 428 * MiB;
constexpr size_t WS_D = 556 * MiB;
constexpr size_t WS_E = 684 * MiB;
constexpr size_t WS_F = 812 * MiB;
constexpr size_t WS_CQ = WS_F, WS_CKV = WS_F + 24 * MiB, WS_QH = WS_F + 40 * MiB, WS_HID = WS_F, WS_DD = WS_F + 104 * MiB  , WS_END = WS_F + 256 * MiB;
static_assert(WS_WIN + (size_t)INWP * DM * 2 <= WS_WUQ && WS_WPLE + (size_t)DM * PLE * 2 <= WS_A && WS_END == 1068 * MiB, "d_ws map");
constexpr int RING_OFF = 0, RING_BYTES = 131072, LDSCTL_OFF = RING_BYTES, MISC_OFF = LDSCTL_OFF + 320, LDS_BYTES = 148480;

#define GAS __attribute__((address_space(1)))
#define LAS __attribute__((address_space(3)))
typedef unsigned short bf16;
typedef unsigned v4u __attribute__((ext_vector_type(4)));
typedef unsigned v2u __attribute__((ext_vector_type(2)));
typedef float f32x4 __attribute__((ext_vector_type(4)));
typedef float f32x2 __attribute__((ext_vector_type(2)));
typedef GAS unsigned gu32;
#define RLX_AGENT __ATOMIC_RELAXED, __HIP_MEMORY_SCOPE_AGENT
#define LDS_WAIT() asm volatile("s_waitcnt lgkmcnt(0)" ::: "memory")
__device__ __forceinline__ unsigned pk2(float lo, float hi) { unsigned r; asm volatile("s_nop 0\n\tv_cvt_pk_bf16_f32 %0, %1, %2" : "=v"(r) : "v"(lo), "v"(hi)); return r; }
__device__ __forceinline__ float bf_lo(unsigned w) { return __uint_as_float(w << 16); }
__device__ __forceinline__ float bf_hi(unsigned w) { return __uint_as_float(w & 0xffff0000u); }

#define XB_TMO      128
#define XB_XCNT(j)  (256  + 64 * (j))
#define XB_XSUB(j)  (1280 + 64 * (j))
#define XB_XGEN(j)  (2304 + 64 * (j))
#define XB_TOP      3328
#define XB_TOPGEN   3392
#define XCD_BAR_WORDS 3456
#define XB_SPIN_CAP (1u << 18)

__device__ __forceinline__ unsigned xb_ld(unsigned* p)              { return __hip_atomic_load(p, __ATOMIC_RELAXED, __HIP_MEMORY_SCOPE_AGENT); }
__device__ __forceinline__ unsigned xb_add(unsigned* p, unsigned v) { return __hip_atomic_fetch_add(p, v, __ATOMIC_RELAXED, __HIP_MEMORY_SCOPE_AGENT); }
__device__ __forceinline__ unsigned xb_xcc_id() { return (unsigned)__builtin_amdgcn_s_getreg((3 << 11) | 20) & 0xFu; }
#define XB_SPIN(cond, bar) do { unsigned _sp = 0; while (cond) { __builtin_amdgcn_s_sleep(1); \
    if ((++_sp & 255u) == 0u) { if (xb_ld(&(bar)[XB_TMO])) break; if (_sp > XB_SPIN_CAP) { atomicAdd(&(bar)[XB_TMO], 1u); break; } } } } while (0)

struct XcdBarrier {
    int wave;
    unsigned* bar; unsigned x;
    volatile LAS unsigned* st;
};

__device__ __forceinline__ XcdBarrier xcd_barrier_post(unsigned* bar, volatile LAS unsigned* st, int wave) {
    XcdBarrier b; b.wave = wave; b.bar = bar; b.x = xb_xcc_id(); b.st = st;
    if (wave == 0 && hw_lane() == 0) (void)xb_add(&bar[XB_XCNT(b.x)], 1u);
    return b;
}
__device__ __forceinline__ void xcd_barrier_complete(unsigned* bar, unsigned x, unsigned& nloc, unsigned& nx) {
    const unsigned G = gridDim.x * gridDim.y * gridDim.z;
    unsigned sum, cnt, mine, sp = 0u;
    for (;;) {
        sum = 0u; cnt = 0u; mine = 0u;
#pragma unroll
        for (unsigned j = 0; j < 16; ++j) { const unsigned c = xb_ld(&bar[XB_XCNT(j)]); sum += c; cnt += (c > 0u) ? 1u : 0u; mine = (j == x) ? c : mine; }
        if (sum == G) break;
        __builtin_amdgcn_s_sleep(1);
        if ((++sp & 255u) == 0u) { if (xb_ld(&bar[XB_TMO])) break; if (sp > XB_SPIN_CAP) { atomicAdd(&bar[XB_TMO], 1u); break; } }
    }
    nloc = mine > 0u ? mine : 1u; nx = cnt > 0u ? cnt : 1u;
}

__device__ __forceinline__ void xcd_barrier(const XcdBarrier& b) {
    asm volatile("s_waitcnt vmcnt(0)" ::: "memory");
    __syncthreads();
    if (b.wave == 0 && hw_lane() == 0) {
        unsigned* bar = b.bar;
        __builtin_amdgcn_s_waitcnt(0);
        unsigned nloc = b.st[0], nx = b.st[1];
        if (nloc == 0u) { xcd_barrier_complete(bar, b.x, nloc, nx); b.st[0] = nloc; b.st[1] = nx; }
        const unsigned old = xb_add(&bar[XB_XSUB(b.x)], 1u);
        const unsigned gen = old / nloc;
        if (old + 1u == (gen + 1u) * nloc) {
            __builtin_amdgcn_fence(__ATOMIC_RELEASE, "agent");
            asm volatile("s_waitcnt vmcnt(0)" ::: "memory");
            const unsigned og = xb_add(&bar[XB_TOP], 1u);
            const unsigned tg = og / nx;
            if (og + 1u == (tg + 1u) * nx) xb_add(&bar[XB_TOPGEN], 1u);
            else XB_SPIN(xb_ld(&bar[XB_TOPGEN]) == tg, bar);
            __builtin_amdgcn_fence(__ATOMIC_ACQUIRE, "agent");
            xb_add(&bar[XB_XGEN(b.x)], 1u);
            asm volatile("s_waitcnt vmcnt(0)" ::: "memory");
        } else {
            XB_SPIN(xb_ld(&bar[XB_XGEN(b.x)]) == gen, bar);
            __builtin_amdgcn_fence(__ATOMIC_ACQUIRE, "agent");
            asm volatile("s_waitcnt vmcnt(0)" ::: "memory");
        }
    }
    __syncthreads();
}

__device__ __forceinline__ float wave_sum(float v) {
#pragma unroll
    for (int o = 1; o < 64; o <<= 1) v += __shfl_xor(v, o);
    return v;
}
struct TrItem { f32x4 v[16]; };
__device__ __forceinline__ void tr_load(TrItem& T, const float* W, int N, int k0, int n0, const float* g, int lane, float wscale) {
    const float* p = W + (size_t)(k0 + (lane >> 4)) * N + n0 + 4 * (lane & 15);
#pragma unroll
    for (int i = 0; i < 16; ++i) { T.v[i] = __builtin_nontemporal_load((const GAS f32x4*)(p + (size_t)(4 * i) * N)); }
    if (g) {
#pragma unroll
        for (int i = 0; i < 16; ++i) T.v[i] = T.v[i] * (g[k0 + 4 * i + (lane >> 4)] * wscale); }
}
template <bool FP8>
__device__ __forceinline__ void tr_store(const TrItem& T, int K, bf16* WT, int k0, int drow0, LAS unsigned* scr, int lane) {
    const int r = lane >> 4, c = lane & 15;
#pragma unroll
    for (int i = 0; i < 16; ++i) { scr[(4 * i + r) * 33 + 2 * c] = pk2(T.v[i].x, T.v[i].y); scr[(4 * i + r) * 33 + 2 * c + 1] = pk2(T.v[i].z, T.v[i].w); }
    LDS_WAIT(); asm volatile("" ::: "memory");
    const int kc = lane & 7;
#pragma unroll
    for (int j = 0; j < 4; ++j) { const int np = 8 * j + (lane >> 3); unsigned d[8];
#pragma unroll
        for (int e = 0; e < 8; ++e) d[e] = scr[(8 * kc + e) * 33 + np];
        if constexpr (FP8) {
            int l0 = 0, l1 = 0, h0 = 0, h1 = 0;
            l0 = __builtin_amdgcn_cvt_pk_fp8_f32(bf_lo(d[0]), bf_lo(d[1]), l0, false); l0 = __builtin_amdgcn_cvt_pk_fp8_f32(bf_lo(d[2]), bf_lo(d[3]), l0, true);
            l1 = __builtin_amdgcn_cvt_pk_fp8_f32(bf_lo(d[4]), bf_lo(d[5]), l1, false); l1 = __builtin_amdgcn_cvt_pk_fp8_f32(bf_lo(d[6]), bf_lo(d[7]), l1, true);
            h0 = __builtin_amdgcn_cvt_pk_fp8_f32(bf_hi(d[0]), bf_hi(d[1]), h0, false); h0 = __builtin_amdgcn_cvt_pk_fp8_f32(bf_hi(d[2]), bf_hi(d[3]), h0, true);
            h1 = __builtin_amdgcn_cvt_pk_fp8_f32(bf_hi(d[4]), bf_hi(d[5]), h1, false); h1 = __builtin_amdgcn_cvt_pk_fp8_f32(bf_hi(d[6]), bf_hi(d[7]), h1, true);
            unsigned char* o = (unsigned char*)WT + (size_t)(drow0 + 2 * np) * K + k0 + 8 * kc;
            *(GAS v2u*)o = (v2u){(unsigned)l0, (unsigned)l1}; *(GAS v2u*)(o + K) = (v2u){(unsigned)h0, (unsigned)h1};
        } else {
        v4u lo, hi;
        lo.x = (d[0] & 0xffffu) | (d[1] << 16); lo.y = (d[2] & 0xffffu) | (d[3] << 16); lo.z = (d[4] & 0xffffu) | (d[5] << 16); lo.w = (d[6] & 0xffffu) | (d[7] << 16);
        hi.x = (d[0] >> 16) | (d[1] & 0xffff0000u); hi.y = (d[2] >> 16) | (d[3] & 0xffff0000u); hi.z = (d[4] >> 16) | (d[5] & 0xffff0000u); hi.w = (d[6] >> 16) | (d[7] & 0xffff0000u);
        bf16* o = WT + (size_t)(drow0 + 2 * np) * K + k0 + 8 * kc;
        *(GAS v4u*)o = lo; *(GAS v4u*)(o + K) = hi; } }
    LDS_WAIT(); asm volatile("" ::: "memory");
}
template <bool FP8 = false>
__device__ __forceinline__ void transpose_matrix(const float* W, int K, int N, bf16* WT, const float* g, LAS float* scrf, int gw, int NGW, int lane, bool is_win, float wscale = 1.0f) {
    LAS unsigned* scr = (LAS unsigned*)scrf;
    const int nblk = N / 64, nitems = (K / 64) * nblk;
    TrItem A, B;
#define TR_LD(X, it_) do { const int kb_ = (it_) / nblk, nb_ = (it_) - kb_ * nblk; tr_load(X, W, N, 64 * kb_, 64 * nb_, g, lane, wscale); } while (0)
#define TR_ST(X, it_) do { const int kb_ = (it_) / nblk, nb_ = (it_) - kb_ * nblk, n0_ = 64 * nb_; tr_store<FP8>(X, K, WT, 64 * kb_, (is_win && n0_ >= 1344) ? n0_ + 192 : n0_, scr, lane); } while (0)
    int it = gw;
    if (it < nitems) TR_LD(A, it);
    while (it < nitems) {
        const int it2 = it + NGW, it3 = it2 + NGW;
        if (it2 < nitems) TR_LD(B, it2);
        TR_ST(A, it);
        if (it2 >= nitems) break;
        if (it3 < nitems) TR_LD(A, it3);
        TR_ST(B, it2);
        it = it3;
    }
#undef TR_LD
#undef TR_ST
}
__device__ __forceinline__ float row_ss_bf16_4096(const bf16* row, int lane) {
    float s = 0.f;
#pragma unroll
    for (int j = 0; j < 8; ++j) { const v4u w = *(const GAS v4u*)(row + 8 * lane + 512 * j);
#pragma unroll
        for (int e = 0; e < 4; ++e) { const float a = bf_lo(w[e]), b = bf_hi(w[e]); s += a * a + b * b; } }
    return wave_sum(s);
}
__device__ __forceinline__ void rstd_rows_4096(const bf16* src, float* dst, int gw, int NGW, int lane) {
    for (int m = gw; m < M; m += NGW) { const float ss = row_ss_bf16_4096(src + (size_t)m * DM, lane); if (lane == 0) dst[m] = 1.0f / sqrtf(ss * (1.0f / DM) + EPS); }
}
__constant__ double ROPE_INVF[32] = {1.0, 0.7498942093324559, 0.5623413251903491, 0.4216965034285822, 0.31622776601683794, 0.23713737056616552, 0.1778279410038923, 0.1333521432163324, 0.1, 0.07498942093324558,
    0.05623413251903491, 0.042169650342858224, 0.03162277660168379, 0.023713737056616554, 0.01778279410038923, 0.01333521432163324, 0.01, 0.007498942093324558, 0.005623413251903491, 0.004216965034285823,
    0.0031622776601683794, 0.0023713737056616554, 0.0017782794100389228, 0.001333521432163324, 0.001, 0.0007498942093324559, 0.0005623413251903491, 0.00042169650342858224, 0.00031622776601683794,
    0.00023713737056616554, 0.00017782794100389227, 0.0001333521432163324};
__device__ __forceinline__ void rope_cs(int pos, int i, float& c, float& s) {
    const double th = (double)pos * ROPE_INVF[i];
    const double k = __builtin_rint(th * 0.6366197723675814);
    double r = __builtin_fma(-k, 1.5707963267948966, th); r = __builtin_fma(-k, 6.123233995736766e-17, r);
    const double r2 = r * r;
    double sp = -1.0 / 39916800.0; sp = __builtin_fma(sp, r2, 1.0 / 362880.0); sp = __builtin_fma(sp, r2, -1.0 / 5040.0); sp = __builtin_fma(sp, r2, 1.0 / 120.0); sp = __builtin_fma(sp, r2, -1.0 / 6.0); sp = __builtin_fma(sp, r2, 1.0); sp *= r;
    double cp = 1.0 / 479001600.0; cp = __builtin_fma(cp, r2, -1.0 / 3628800.0); cp = __builtin_fma(cp, r2, 1.0 / 40320.0); cp = __builtin_fma(cp, r2, -1.0 / 720.0); cp = __builtin_fma(cp, r2, 1.0 / 24.0); cp = __builtin_fma(cp, r2, -0.5); cp = __builtin_fma(cp, r2, 1.0);
    const int q = (int)((long long)k & 3);
    const double sv = (q == 0) ? sp : (q == 1) ? cp : (q == 2) ? -sp : -cp;
    const double cv = (q == 0) ? cp : (q == 1) ? -sp : (q == 2) ? -cp : sp;
    c = (float)cv; s = (float)sv;
}


struct Args { const float* in[20]; float* out; unsigned char* ws; int ph_lo, ph_hi; };
__global__ void __launch_bounds__(NWAVES * 64, 2) hymba_fwd(Args args) {
    extern __shared__ __attribute__((aligned(16))) unsigned char lds_raw[];
    LAS unsigned char* lds = (LAS unsigned char*)lds_raw;
    const int wave = __builtin_amdgcn_readfirstlane((int)threadIdx.x >> 6);
#define lane hw_lane()
#define tid (wave * 64 + hw_lane())
    const int G = gridDim.x; const int bx = blockIdx.x; const int vcu = (G % 8 == 0) ? (bx % 8) * (G / 8) + bx / 8 : bx;
    const int gw = vcu * NWAVES + wave, NGW = G * NWAVES;
    gu32* ctl = (gu32*)(args.ws + WS_CTL);
#define x_in (args.in[0])
#define p_in (args.in[1])
#define positions ((const int*)args.in[2])
#define norm_mix (args.in[3])
#define w_in (args.in[4])
#define q_a_norm (args.in[5])
#define kv_a_norm (args.in[6])
#define w_uq (args.in[7])
#define w_ukv (args.in[8])
#define hg_lb (args.in[9])
#define hg_out_norm (args.in[10])
#define w_o (args.in[11])
#define norm_mlp (args.in[12])
#define w_up (args.in[13])
#define w_down (args.in[14])
#define norm_ple (args.in[15])
#define w_pg (args.in[16])
#define w_ple (args.in[17])
#define ple_post (args.in[18])
#define final_norm (args.in[19])
#define out (args.out)
#define RSX ((float*)(ws + WS_RSX))
#define RSQ ((float*)(ws + WS_RSQ))
#define RSKV ((float*)(ws + WS_RSKV))
#define RS1 ((float*)(ws + WS_RS1))
#define RS2 ((float*)(ws + WS_RS2))
#define RSE ((float*)(ws + WS_RSE))
#define LB ((float*)(ws + WS_LB))
#define RC ((float*)(ws + WS_RC))
#define RSN ((float*)(ws + WS_RSN))
#define KRAW ((float*)(ws + WS_KRAW))
#define KR ((bf16*)(ws + WS_KR))
#define PB ((bf16*)(ws + WS_PB))
#define WIN ((bf16*)(ws + WS_WIN))
#define WUQ ((bf16*)(ws + WS_WUQ))
#define WUKV ((bf16*)(ws + WS_WUKV))
#define WO ((bf16*)(ws + WS_WO))
#define WPG ((bf16*)(ws + WS_WPG))
#define WPLE ((bf16*)(ws + WS_WPLE))
#define H2F ((unsigned char*)(ws + WS_WIN))
#define XB ((bf16*)(ws + WS_A))
#define MIX ((bf16*)(ws + WS_MIX))
#define H2B ((bf16*)(ws + WS_A))
#define KV ((bf16*)(ws + WS_B))
#define H1B ((bf16*)(ws + WS_B))
#define Q ((bf16*)(ws + WS_C))
#define WUP ((bf16*)(ws + WS_C))
#define WDN ((bf16*)(ws + WS_D))
#define VH ((bf16*)(ws + WS_E))
#define GH ((bf16*)(ws + WS_E + 64 * MiB))
#define EB ((bf16*)(ws + WS_E))
#define CQ ((bf16*)(ws + WS_CQ))
#define CKV ((bf16*)(ws + WS_CKV))
#define QH ((bf16*)(ws + WS_QH))
#define HID ((bf16*)(ws + WS_HID))
#define ws (args.ws)
#define FF ((bf16*)out)
#define UT ((bf16*)(ws + WS_D))
#define DDK ((float*)(ws + WS_DD))

    for (int u = tid; u < (LDS_BYTES - LDSCTL_OFF) / 4; u += NWAVES * 64) ((LAS unsigned*)(lds + LDSCTL_OFF))[u] = 0u;
    __syncthreads();
    volatile LAS unsigned* MISC = (volatile LAS unsigned*)(lds + MISC_OFF);
    XcdBarrier bar; bar.wave = wave; bar.bar = (unsigned*)(ctl + 1024); bar.x = 0; bar.st = nullptr;
    if (MK_ONE_LAUNCH) bar = xcd_barrier_post((unsigned*)(ctl + 1024), MISC + 8, wave);
    const int lo = args.ph_lo, hi = args.ph_hi;
#define IN(k) (lo <= (k) && (k) < hi)
#define SEAM(k) do { if (IN(k) && IN((k) + 1)) xcd_barrier(bar); } while (0)
    LAS float* scr = (LAS float*)(lds + RING_OFF + wave * 16384);

    if (IN(0)) {
        transpose_matrix(w_in, DM, INW, WIN, norm_mix, scr, gw, NGW, lane, true);
        transpose_matrix(w_uq, QLORA, 3072, WUQ, q_a_norm, scr, gw, NGW, lane, false);
        transpose_matrix(w_ukv, KVLORA, 4096, WUKV, kv_a_norm, scr, gw, NGW, lane, false);
        { const int gt = gw * 64 + lane, NGT = NGW * 64;
          for (int i = gt; i < 192 * DM / 8; i += NGT) *(GAS v4u*)(WIN + (size_t)1344 * DM + (size_t)i * 8) = (v4u){0u, 0u, 0u, 0u};
          for (int i = gt; i < M * 32; i += NGT) { float c, s; rope_cs(positions[i >> 5], i & 31, c, s); RC[i] = c; RSN[i] = s; }
          for (int i = gt; i < HGD; i += NGT) LB[i] = 1.0f / (1.0f + expf(hg_lb[HGD + i] - hg_lb[i]));
          for (int i = gt; i < M; i += NGT) { RS1[i] = 0.f; RS2[i] = 0.f; RSE[i] = 0.f; RSQ[i] = 0.f; RSKV[i] = 0.f; }
          for (int i = gt; i < M * PLE / 8; i += NGT) { const f32x4 a = *(const GAS f32x4*)(p_in + (size_t)i * 8), b = *(const GAS f32x4*)(p_in + (size_t)i * 8 + 4);
              *(GAS v4u*)(PB + (size_t)i * 8) = (v4u){pk2(a.x, a.y), pk2(a.z, a.w), pk2(b.x, b.y), pk2(b.z, b.w)}; } }
        for (int m = gw; m < M; m += NGW) { const GAS f32x4* xr = (const GAS f32x4*)(x_in + (size_t)m * DM) + lane; f32x4 v[16]; float s = 0.f;
#pragma unroll
            for (int j = 0; j < 16; ++j) { v[j] = __builtin_nontemporal_load(xr + 64 * j); s += (v[j].x * v[j].x + v[j].y * v[j].y) + (v[j].z * v[j].z + v[j].w * v[j].w); }
            s = wave_sum(s); if (lane == 0) RSX[m] = 1.0f / sqrtf(s * (1.0f / DM) + EPS);
            GAS v2u* o8 = (GAS v2u*)(XB + (size_t)m * DM) + lane;
#pragma unroll
            for (int j = 0; j < 16; ++j) o8[64 * j] = (v2u){pk2(v[j].x, v[j].y), pk2(v[j].z, v[j].w)}; }
    }
    SEAM(0);
    if (IN(1)) {
        pg8::Gemm g{XB, WIN, M, INWP, DM}; pg8::StaticOrder S; S.init(M, INWP, G, bx);
        pg8::EpiProj E{CQ, CKV, KRAW, QH, FF, VH, GH, RSX, LB, RSQ, RSKV};
        pg8::gemm_phase<pg8::EpiProj, pg8::StaticOrder, true, true>(lds + RING_OFF, g, S, E, wave);
        { const int nwg = (M / 256) * (INWP / 256), R = (nwg + G - 1) / G, nshort = R * G - nwg; const int first = (nshort == 0) ? 0 : G - nshort, cnt = (nshort == 0) ? G : nshort;
          if (bx >= first) { const int gw2 = (bx - first) * NWAVES + wave, NGW2 = cnt * NWAVES;
              transpose_matrix(w_o, DM, DM, WO, nullptr, scr, gw2, NGW2, lane, false);
              transpose_matrix<true>(w_pg, DM, DM, WPG, norm_ple, scr, gw2, NGW2, lane, false, 64.0f);
              transpose_matrix(w_ple, PLE, DM, WPLE, nullptr, scr, gw2, NGW2, lane, false); } }
    }
    SEAM(1);
    if (IN(2)) {
        for (int i = gw * 64 + lane; i < M * 32; i += NGW * 64) { const int m = i >> 5, l = i & 31;
            const float x1 = KRAW[(size_t)m * 64 + l], x2 = KRAW[(size_t)m * 64 + 32 + l], c = RC[i], sn = RSN[i];
            KR[(size_t)m * 64 + l] = (bf16)(pk2(x1 * c - x2 * sn, 0.f) & 0xffffu); KR[(size_t)m * 64 + 32 + l] = (bf16)(pk2(x2 * c + x1 * sn, 0.f) & 0xffffu); }
        hg::pass1_all(FF, VH, UT, DDK, vcu, G, (LAS char*)(lds + RING_OFF), wave);
    }
    SEAM(2);
    if (IN(3)) {
        { pg8::Gemm g{CQ, WUQ, M, 3072, QLORA}; pg8::StaticOrder S; S.init(M, 3072, G, bx); pg8::EpiRowScale E{Q, 3072, RSQ, QSCALE, nullptr, 1.0f / QLORA, EPS};
          pg8::gemm_phase<pg8::EpiRowScale, pg8::StaticOrder, true, true>(lds + RING_OFF, g, S, E, wave); }
        { pg8::Gemm g{CKV, WUKV, M, 4096, KVLORA}; pg8::StaticOrder S; S.init(M, 4096, G, bx); pg8::EpiRowScale E{KV, 4096, RSKV, 1.0f, nullptr, 1.0f / KVLORA, EPS};
          pg8::gemm_phase<pg8::EpiRowScale, pg8::StaticOrder, true, true>(lds + RING_OFF, g, S, E, wave); }
        hg::pass2_scan(UT, DDK, gw * 64 + lane, NGW * 64);
    }
    SEAM(3);
    if (IN(4)) {
        const att::Tensors T{Q, KV, KR, RC, RSN, MIX};
        for (int pi = vcu; pi < 512; pi += G) { const int bh = pi >> 3, s = pi & 7; att::unit(T, bh, 15 - s, (LAS char*)(lds + RING_OFF), wave); att::unit(T, bh, s, (LAS char*)(lds + RING_OFF), wave); }
        hg::pass3_all(FF, QH, VH, GH, UT, hg_out_norm, MIX, vcu, G, (LAS char*)(lds + RING_OFF), wave);
    }
    SEAM(4);
    if (IN(5)) {
        const bool conv_first = (G % 8 == 0) ? (((vcu / (G / 8)) & 1) != 0) : ((vcu & 1) != 0);
        if (conv_first) { transpose_matrix(w_up, DM, DFF, WUP, norm_mlp, scr, gw, NGW, lane, false); transpose_matrix(w_down, DFF, DM, WDN, nullptr, scr, gw, NGW, lane, false); __syncthreads(); }
        { pg8::Gemm g{MIX, WO, M, DM, DM}; pg8::StaticOrder S; S.init(M, DM, G, bx); pg8::EpiResidB E{XB, H1B, nullptr, DM, RS1, false, true};
          pg8::gemm_phase<pg8::EpiResidB, pg8::StaticOrder, true, true>(lds + RING_OFF, g, S, E, wave); }
        { pg8::Gemm g{PB, WPLE, M, DM, PLE}; pg8::StaticOrder S; S.init(M, DM, G, bx); pg8::EpiRowScale E{EB, DM, nullptr, 1.0f, RSE, 0.f, 0.f};
          pg8::gemm_phase<pg8::EpiRowScale, pg8::StaticOrder, true, true>(lds + RING_OFF, g, S, E, wave); }
        if (!conv_first) { transpose_matrix(w_up, DM, DFF, WUP, norm_mlp, scr, gw, NGW, lane, false); transpose_matrix(w_down, DFF, DM, WDN, nullptr, scr, gw, NGW, lane, false); }
    }
    SEAM(5);
    if (IN(7)) { pg8::Gemm g{H1B, WUP, M / 2, DFF, DM}; pg8::StaticOrder S; S.init(M / 2, DFF, G, bx); pg8::EpiRelu2 E{HID, DFF, RS1, 1.0f / DM, EPS};
        pg8::gemm_phase<pg8::EpiRelu2, pg8::StaticOrder, true, true, false, true>(lds + RING_OFF, g, S, E, wave); }
    SEAM(7);
    if (IN(8)) { pg8::Gemm g{HID, WDN, M / 2, DM, DFF}; pg8::StaticOrder S; S.init(M / 2, DM, G, bx); pg8::EpiResidB E{H1B, H2B, H2F, DM, RS2, true, false};
        pg8::gemm_phase<pg8::EpiResidB, pg8::StaticOrder, true, true, false, true>(lds + RING_OFF, g, S, E, wave); }
    SEAM(8);
    if (IN(9)) { pg8::Gemm g{H1B + (size_t)(M / 2) * DM, WUP, M / 2, DFF, DM}; pg8::StaticOrder S; S.init(M / 2, DFF, G, bx); pg8::EpiRelu2 E{HID, DFF, RS1 + M / 2, 1.0f / DM, EPS};
        pg8::gemm_phase<pg8::EpiRelu2, pg8::StaticOrder, true, true, false, true>(lds + RING_OFF, g, S, E, wave); }
    SEAM(9);
    if (IN(10)) { pg8::Gemm g{HID, WDN, M / 2, DM, DFF}; pg8::StaticOrder S; S.init(M / 2, DM, G, bx); pg8::EpiResidB E{H1B + (size_t)(M / 2) * DM, H2B + (size_t)(M / 2) * DM, H2F + (size_t)(M / 2) * DM, DM, RS2 + M / 2, true, false};
        pg8::gemm_phase<pg8::EpiResidB, pg8::StaticOrder, true, true, false, true>(lds + RING_OFF, g, S, E, wave); }
    SEAM(10);
    if (IN(12)) { pg8::Gemm g{(const bf16*)H2F, WPG, M, DM, DM / 2}; pg8::StaticOrder S; S.init(M, DM, G, bx); pg8::EpiGateOnly E{(unsigned char*)WUP, RS2, DM, 1.0f / 64.0f, 1.0f / DM, EPS};
        pg8::gemm_phase<pg8::EpiGateOnly, pg8::StaticOrder, true, true, true, true>(lds + RING_OFF, g, S, E, wave); }
    SEAM(12);
    if (IN(13)) {
        for (int m = gw; m < M; m += NGW) {
            const bf16* hr = H2B + (size_t)m * DM + 8 * lane; const unsigned char* gr = (const unsigned char*)WUP + (size_t)m * DM + 8 * lane; const bf16* er = EB + (size_t)m * DM + 8 * lane;
            v4u wh[8], we[8]; v2u wg[8];
#pragma unroll
            for (int j = 0; j < 8; ++j) { wh[j] = *(const GAS v4u*)(hr + 512 * j); wg[j] = *(const GAS v2u*)(gr + 512 * j); we[j] = *(const GAS v4u*)(er + 512 * j); }
            const float rse = 1.0f / sqrtf(RSE[m] * (1.0f / DM) + EPS);
            float h3[64]; float s = 0.f;
#pragma unroll
            for (int j = 0; j < 8; ++j) { const f32x4 p0 = *(const GAS f32x4*)(ple_post + 8 * lane + 512 * j), p1 = *(const GAS f32x4*)(ple_post + 8 * lane + 512 * j + 4);
#pragma unroll
                for (int e = 0; e < 4; ++e) { const float pl = e < 2 ? p0[2 * e] : p1[2 * e - 4], ph = e < 2 ? p0[2 * e + 1] : p1[2 * e - 3];
                    const unsigned gq = wg[j][e >> 1] >> (16 * (e & 1)); const float gl = (float)(gq & 0xffu) * (1.0f / 255.0f), gh = (float)((gq >> 8) & 0xffu) * (1.0f / 255.0f);
                    const float a = bf_lo(wh[j][e]) + gl * (bf_lo(we[j][e]) * rse * pl), b = bf_hi(wh[j][e]) + gh * (bf_hi(we[j][e]) * rse * ph);
                    h3[8 * j + 2 * e] = a; h3[8 * j + 2 * e + 1] = b; s += a * a + b * b; } }
            s = wave_sum(s); const float rstd = 1.0f / sqrtf(s * (1.0f / DM) + EPS);
            float* orow = out + (size_t)m * DM + 8 * lane;
#pragma unroll
            for (int j = 0; j < 8; ++j) { const f32x4 g0 = *(const GAS f32x4*)(final_norm + 8 * lane + 512 * j), g1 = *(const GAS f32x4*)(final_norm + 8 * lane + 512 * j + 4);
                f32x4 o0, o1; o0.x = h3[8 * j] * rstd * g0.x; o0.y = h3[8 * j + 1] * rstd * g0.y; o0.z = h3[8 * j + 2] * rstd * g0.z; o0.w = h3[8 * j + 3] * rstd * g0.w;
                o1.x = h3[8 * j + 4] * rstd * g1.x; o1.y = h3[8 * j + 5] * rstd * g1.y; o1.z = h3[8 * j + 6] * rstd * g1.z; o1.w = h3[8 * j + 7] * rstd * g1.w;
                __builtin_nontemporal_store(o0, (GAS f32x4*)(orow + 512 * j)); __builtin_nontemporal_store(o1, (GAS f32x4*)(orow + 512 * j + 4)); }
        }
    }
#undef IN
#undef SEAM
#undef lane
#undef tid
#undef x_in
#undef p_in
#undef positions
#undef norm_mix
#undef w_in
#undef q_a_norm
#undef kv_a_norm
#undef w_uq
#undef w_ukv
#undef hg_lb
#undef hg_out_norm
#undef w_o
#undef norm_mlp
#undef w_up
#undef w_down
#undef norm_ple
#undef w_pg
#undef w_ple
#undef ple_post
#undef final_norm
#undef out
#undef RSX
#undef RSQ
#undef RSKV
#undef RS1
#undef RS2
#undef RSE
#undef LB
#undef RC
#undef RSN
#undef KRAW
#undef KR
#undef PB
#undef WIN
#undef WUQ
#undef WUKV
#undef WO
#undef WPG
#undef WPLE
#undef H2F
#undef XB
#undef MIX
#undef H2B
#undef KV
#undef H1B
#undef Q
#undef WUP
#undef WDN
#undef VH
#undef GH
#undef EB
#undef CQ
#undef CKV
#undef QH
#undef HID
#undef ws
#undef FF
#undef UT
#undef DDK
}

extern "C" void kernel_launch(void* const* d_in, const int* in_sizes, int n_in, void* d_out, int out_size, void* d_ws, size_t ws_size, hipStream_t stream) {
    static int grid = 0;
    if (grid == 0) {
        if (n_in != 20 || in_sizes[0] != M * DM || out_size != M * DM || ws_size < WS_END) { fprintf(stderr, "kernel_launch: unexpected shapes (n_in %d, in0 %d, out %d, ws %zu); nothing launched\n", n_in, n_in > 0 ? in_sizes[0] : -1, out_size, ws_size); grid = -1; return; }
        int dev = 0, cus = 0, per_cu = 0;
        if (hipGetDevice(&dev) != hipSuccess || hipDeviceGetAttribute(&cus, hipDeviceAttributeMultiprocessorCount, dev) != hipSuccess) { grid = -1; return; }
        if (hipFuncSetAttribute((const void*)hymba_fwd, hipFuncAttributeMaxDynamicSharedMemorySize, LDS_BYTES) != hipSuccess) { fprintf(stderr, "kernel_launch: hipFuncSetAttribute failed\n"); grid = -1; return; }
        if (hipOccupancyMaxActiveBlocksPerMultiprocessor(&per_cu, (const void*)hymba_fwd, NWAVES * 64, LDS_BYTES) != hipSuccess || per_cu < 1) fprintf(stderr, "kernel_launch: occupancy query reports %d workgroups per CU\n", per_cu);
        (void)hipGetLastError();
        grid = cus;
    }
    if (grid < 0) return;
    if (hipMemsetAsync((char*)d_ws + WS_CTL, 0, CTL_ZERO_BYTES, stream) != hipSuccess) return;
    Args a{};
    for (int i = 0; i < 20; ++i) a.in[i] = (const float*)d_in[i];
    a.out = (float*)d_out; a.ws = (unsigned char*)d_ws;
#if PROBE_DUP >= 0
    a.ph_lo = 0; a.ph_hi = PROBE_DUP + 1;
    hipLaunchKernelGGL(hymba_fwd, dim3(grid), dim3(NWAVES * 64), LDS_BYTES, stream, a);
    (void)hipMemsetAsync((char*)d_ws + WS_CTL, 0, CTL_ZERO_BYTES, stream);
    a.ph_lo = PROBE_DUP; a.ph_hi = N_PHASES;
    hipLaunchKernelGGL(hymba_fwd, dim3(grid), dim3(NWAVES * 64), LDS_BYTES, stream, a);
#elif MK_ONE_LAUNCH
    a.ph_lo = 0; a.ph_hi = N_PHASES;
    hipLaunchKernelGGL(hymba_fwd, dim3(grid), dim3(NWAVES * 64), LDS_BYTES, stream, a);
#else
    for (int li = 0; li < N_PHASES; ++li) { a.ph_lo = li; a.ph_hi = li + 1; hipLaunchKernelGGL(hymba_fwd, dim3(grid), dim3(NWAVES * 64), LDS_BYTES, stream, a); }
#endif
}
```

```cpp
#include <hip/hip_runtime.h>
#include <cstdio>
#include <cstdint>
__device__ __forceinline__ int hw_lane() { int l; asm volatile("v_mbcnt_lo_u32_b32 %0, -1, 0\n\tv_mbcnt_hi_u32_b32 %0, -1, %0" : "=v"(l)); return l; }
namespace pg8 {
#define PG8_LAS __attribute__((address_space(3)))
typedef unsigned short bf16_t;
typedef short bf16x8 __attribute__((ext_vector_type(8)));
typedef float f32x4 __attribute__((ext_vector_type(4)));
typedef unsigned u32x4 __attribute__((ext_vector_type(4)));
typedef int v4i32 __attribute__((ext_vector_type(4)));
typedef int v8i32 __attribute__((ext_vector_type(8)));
constexpr int BM = 256, BK = 64, HALF = 128, HTB = HALF * BK * 2  , STAGE_BYTES = 8 * HTB, NXCD = 8, WGM = 8;

__host__ __device__ __forceinline__ int lds_byte(int r, int c) { const int st = (r >> 4) * 2 + (c >> 5), rr = r & 15, cc = c & 31, ob = rr * 64 + cc * 2; return st * 1024 + (ob ^ (((ob >> 9) & 1) << 5)); }
__host__ __device__ __forceinline__ void stage_rc(int b, int& R, int& C) { const int st = b / 1024, sb = b % 1024, swz = sb ^ (((sb >> 9) & 1) << 5); R = (st >> 1) * 16 + swz / 64; C = (st & 1) * 32 + (swz % 64) / 2; }
__host__ __device__ __forceinline__ int perm32(int rho) { const int n = rho >> 4, i = rho & 15; return 8 * (i >> 2) + 4 * n + (i & 3); }

struct Unit { int pm, pn; };
struct Gemm { const bf16_t* A; const bf16_t* Bt; int M, N, K; };

struct StaticOrder {
    int nM, nN, nwg, G, c;
    __host__ __device__ void init(int M, int N, int G_, int c_) { nM = M / BM; nN = N / BM; nwg = nM * nN; G = G_; c = c_; }
    __host__ __device__ bool next(int i, Unit& u) const {
        const long L = (long)i * G + c; if (L >= nwg) return false;
        int wgid = (int)L; { const int q = nwg / NXCD, r = nwg % NXCD, xcd = wgid % NXCD, off = wgid / NXCD; wgid = (xcd < r ? xcd * (q + 1) : r * (q + 1) + (xcd - r) * q) + off; }
        const int nig = WGM * nN, gid = wgid / nig, fm = gid * WGM, gsz = (nM - fm) < WGM ? (nM - fm) : WGM;
        u.pm = fm + ((wgid % nig) % gsz); u.pn = (wgid % nig) / gsz; return true;
    }
    __device__ __forceinline__ void a_ready(const Unit&) const {}
    __device__ __forceinline__ void done(const Unit&) const {}
};

__device__ __forceinline__ unsigned cvt_pk_bf16(float lo, float hi) { unsigned r; asm volatile("s_nop 0\n\tv_cvt_pk_bf16_f32 %0, %1, %2" : "=v"(r) : "v"(lo), "v"(hi)); return r; }
typedef float f32x2 __attribute__((ext_vector_type(2)));
typedef unsigned u32x2 __attribute__((ext_vector_type(2)));
__device__ __forceinline__ float sigmoidf_(float z) { return __builtin_amdgcn_rcpf(1.0f + __builtin_amdgcn_exp2f(-1.4426950408889634f * z)); }
__device__ __forceinline__ u32x4 pack8(f32x4 a, f32x4 b) { u32x4 w; w.x = cvt_pk_bf16(a[0], a[1]); w.y = cvt_pk_bf16(a[2], a[3]); w.z = cvt_pk_bf16(b[0], b[1]); w.w = cvt_pk_bf16(b[2], b[3]); return w; }

__device__ __forceinline__ void row_sumsq_add(float* accp, float s, int fq) { s += __shfl_xor(s, 16); s += __shfl_xor(s, 32); if (fq == 0) atomicAdd(accp, s); }
__device__ __forceinline__ float sq4(f32x4 v) { return (v[0] * v[0] + v[1] * v[1]) + (v[2] * v[2] + v[3] * v[3]); }

__device__ __forceinline__ size_t tiled_off(int r, int c, int ldc) { return ((size_t)(r >> 4) * (ldc >> 5) + (c >> 5)) * 512 + (r & 15) * 32 + (c & 31); }
__device__ __forceinline__ size_t tiled_off8(int r, int c, int ldc) { return ((size_t)(r >> 4) * (ldc >> 6) + (c >> 6)) * 1024 + (r & 15) * 64 + (c & 63); }
struct EpiProj {
    static constexpr bool PERM = true, AFTER_DRAIN = false;
    bf16_t* CQ; bf16_t* CKV; float* KRAW; bf16_t* QH; bf16_t* KF; bf16_t* VH; bf16_t* GH; const float* rstd; const float* LB; float* ssq_q; float* ssq_kv;
    __device__ __forceinline__ void operator()(const f32x4 (&acc)[2][2][4][2], const Unit& u, int wr, int wc, int fr, int fq) const {
        const int row0 = u.pm * BM + wr * 64 + fr, t = u.pn, cl = wc * 32 + 8 * fq;
        int cat, cbase;
        if (t < 3) { cat = 0; cbase = t * 256; } else if (t < 5) { cat = 1; cbase = (t - 3) * 256; } else if (t == 5) { cat = 2; cbase = 0; }
        else if (t < 14) { cat = 3; cbase = (t - 6) * 256; } else if (t < 22) { cat = 4; cbase = (t - 14) * 256; } else if (t < 30) { cat = 5; cbase = (t - 22) * 256; } else { cat = 6; cbase = (t - 30) * 256; }
        float rs[2][4];
#pragma unroll
        for (int ai = 0; ai < 2; ++ai)
#pragma unroll
            for (int m = 0; m < 4; ++m) rs[ai][m] = rstd[row0 + ai * HALF + m * 16];
        f32x4 lb[2][2];
#pragma unroll
        for (int bj = 0; bj < 2; ++bj) { lb[bj][0] = (f32x4){0.f, 0.f, 0.f, 0.f}; lb[bj][1] = lb[bj][0]; if (cat == 4) { lb[bj][0] = *(const f32x4*)(LB + cbase + bj * HALF + cl); lb[bj][1] = *(const f32x4*)(LB + cbase + bj * HALF + cl + 4); } }
#pragma unroll
        for (int ai = 0; ai < 2; ++ai)
#pragma unroll
            for (int m = 0; m < 4; ++m) { const int row = row0 + ai * HALF + m * 16; const float rsv = rs[ai][m]; float qs = 0.f;
#pragma unroll
                for (int bj = 0; bj < 2; ++bj) { const int col = cbase + bj * HALF + cl; f32x4 v0 = acc[ai][bj][m][0] * rsv, v1 = acc[ai][bj][m][1] * rsv;
                    if (cat == 0) { *(u32x4*)(CQ + (size_t)row * 768 + col) = pack8(v0, v1); qs += sq4(v0) + sq4(v1); }
                    else if (cat == 1) { *(u32x4*)(CKV + (size_t)row * 512 + col) = pack8(v0, v1); qs += sq4(v0) + sq4(v1); }
                    else if (cat == 2) { if (bj == 0 && wc < 2) { *(f32x4*)(KRAW + (size_t)row * 64 + col) = v0; *(f32x4*)(KRAW + (size_t)row * 64 + col + 4) = v1; } }
                    else if (cat == 3 || cat == 6) {
#pragma unroll
                        for (int e = 0; e < 4; ++e) { v0[e] = v0[e] * sigmoidf_(v0[e]); v1[e] = v1[e] * sigmoidf_(v1[e]); }
                        *(u32x4*)((cat == 3 ? QH : GH) + (size_t)row * 2048 + col) = pack8(v0, v1); }
                    else if (cat == 4) { const f32x4 l0 = lb[bj][0], l1 = lb[bj][1];
#pragma unroll
                        for (int e = 0; e < 4; ++e) { v0[e] = (1.0f - l0[e]) * sigmoidf_(-v0[e]); v1[e] = (1.0f - l1[e]) * sigmoidf_(-v1[e]); }
                        *(u32x4*)(KF + (size_t)row * 2048 + col) = pack8(v0, v1); }
                    else { *(u32x4*)(VH + (size_t)row * 2048 + col) = pack8(v0, v1); }
                }
                if (cat == 0) row_sumsq_add(ssq_q + row, qs, fq); else if (cat == 1) row_sumsq_add(ssq_kv + row, qs, fq); }
    }
};
struct EpiRowScale {
    static constexpr bool PERM = true, AFTER_DRAIN = false;
    bf16_t* O; int ldc; const float* rs; float scale; float* ssq; float inv_n, eps;
    __device__ __forceinline__ void operator()(const f32x4 (&acc)[2][2][4][2], const Unit& u, int wr, int wc, int fr, int fq) const {
        const int row0 = u.pm * BM + wr * 64 + fr, col0 = u.pn * BM + wc * 32 + 8 * fq;
        float sv[2][4];
#pragma unroll
        for (int ai = 0; ai < 2; ++ai)
#pragma unroll
            for (int m = 0; m < 4; ++m) sv[ai][m] = (rs ? 1.0f / sqrtf(rs[row0 + ai * HALF + m * 16] * inv_n + eps) : 1.0f) * scale;
#pragma unroll
        for (int ai = 0; ai < 2; ++ai)
#pragma unroll
            for (int m = 0; m < 4; ++m) { const int row = row0 + ai * HALF + m * 16; const float s = sv[ai][m]; float q = 0.f;
#pragma unroll
                for (int bj = 0; bj < 2; ++bj) { const f32x4 v0 = acc[ai][bj][m][0] * s, v1 = acc[ai][bj][m][1] * s; q += sq4(v0) + sq4(v1);
                    *(u32x4*)(O + (size_t)row * ldc + col0 + bj * HALF) = pack8(v0, v1); }
                if (ssq) row_sumsq_add(ssq + row, q, fq); }
    }
};
struct EpiRelu2 {
    static constexpr bool PERM = true, AFTER_DRAIN = false;
    bf16_t* O; int ldc; const float* ssq; float inv_n, eps;
    __device__ __forceinline__ void operator()(const f32x4 (&acc)[2][2][4][2], const Unit& u, int wr, int wc, int fr, int fq) const {
        const int row0 = u.pm * BM + wr * 64 + fr, col0 = u.pn * BM + wc * 32 + 8 * fq;
        float sv[2][4];
#pragma unroll
        for (int ai = 0; ai < 2; ++ai)
#pragma unroll
            for (int m = 0; m < 4; ++m) sv[ai][m] = 1.0f / sqrtf(ssq[row0 + ai * HALF + m * 16] * inv_n + eps);
#pragma unroll
        for (int ai = 0; ai < 2; ++ai)
#pragma unroll
            for (int m = 0; m < 4; ++m) { const int row = row0 + ai * HALF + m * 16; const float s = sv[ai][m];
#pragma unroll
                for (int bj = 0; bj < 2; ++bj) { f32x4 v0 = acc[ai][bj][m][0] * s, v1 = acc[ai][bj][m][1] * s;
#pragma unroll
                    for (int e = 0; e < 4; ++e) { const float a = fmaxf(v0[e], 0.f), b = fmaxf(v1[e], 0.f); v0[e] = a * a; v1[e] = b * b; }
                    *(u32x4*)(O + ((size_t)(row >> 4) * (ldc >> 5) + ((col0 + bj * HALF) >> 5)) * 512 + (row & 15) * 32 + (col0 & 31)) = pack8(v0, v1); } }
    }
};
struct EpiResidX {
    static constexpr bool PERM = true, AFTER_DRAIN = false;
    const float* base; bf16_t* hb; int ldc; float* ssq;
    __device__ __forceinline__ void ldg(f32x4 (&b)[2][2][2], int grp, size_t off0) const {
#pragma unroll
        for (int mm = 0; mm < 2; ++mm)
#pragma unroll
            for (int bj = 0; bj < 2; ++bj)
#pragma unroll
                for (int n = 0; n < 2; ++n) b[mm][bj][n] = *(const f32x4*)(base + off0 + (size_t)((grp >> 1) * HALF + ((grp & 1) * 2 + mm) * 16) * ldc + bj * HALF + n * 4);
    }
    __device__ __forceinline__ void stg(const f32x4 (&b)[2][2][2], const f32x4 (&acc)[2][2][4][2], int grp, size_t off0, int row0, int fq) const {
        const int ai = grp >> 1;
#pragma unroll
        for (int mm = 0; mm < 2; ++mm) { const int m = (grp & 1) * 2 + mm; float q = 0.f;
#pragma unroll
            for (int bj = 0; bj < 2; ++bj) { const size_t o2 = off0 + (size_t)(ai * HALF + m * 16) * ldc + bj * HALF; const f32x4 v0 = b[mm][bj][0] + acc[ai][bj][m][0], v1 = b[mm][bj][1] + acc[ai][bj][m][1]; q += sq4(v0) + sq4(v1);
                *(u32x4*)(hb + o2) = pack8(v0, v1); }
            row_sumsq_add(ssq + row0 + ai * HALF + m * 16, q, fq); }
    }
    __device__ __forceinline__ void operator()(const f32x4 (&acc)[2][2][4][2], const Unit& u, int wr, int wc, int fr, int fq) const {
        const int row0 = u.pm * BM + wr * 64 + fr; const size_t off0 = (size_t)row0 * ldc + u.pn * BM + wc * 32 + 8 * fq;
        f32x4 b0[2][2][2], b1[2][2][2];
        ldg(b0, 0, off0); ldg(b1, 1, off0);
        stg(b0, acc, 0, off0, row0, fq); ldg(b0, 2, off0);
        stg(b1, acc, 1, off0, row0, fq); ldg(b1, 3, off0);
        stg(b0, acc, 2, off0, row0, fq); stg(b1, acc, 3, off0, row0, fq);
    }
};
__device__ __forceinline__ void unpack8(u32x4 w, f32x4& a, f32x4& b) {
    a[0] = __uint_as_float(w.x << 16); a[1] = __uint_as_float(w.x & 0xffff0000u); a[2] = __uint_as_float(w.y << 16); a[3] = __uint_as_float(w.y & 0xffff0000u);
    b[0] = __uint_as_float(w.z << 16); b[1] = __uint_as_float(w.z & 0xffff0000u); b[2] = __uint_as_float(w.w << 16); b[3] = __uint_as_float(w.w & 0xffff0000u);
}
struct EpiResidB {
    static constexpr bool PERM = true, AFTER_DRAIN = false;
    const bf16_t* hin; bf16_t* hout; unsigned char* hf8; int ldc; float* ssq; bool tin, tout;
    __device__ __forceinline__ void operator()(const f32x4 (&acc)[2][2][4][2], const Unit& u, int wr, int wc, int fr, int fq) const {
        const int row0 = u.pm * BM + wr * 64 + fr, col0 = u.pn * BM + wc * 32 + 8 * fq;
        u32x4 b[2][4][2];
#pragma unroll
        for (int ai = 0; ai < 2; ++ai)
#pragma unroll
            for (int m = 0; m < 4; ++m)
#pragma unroll
                for (int bj = 0; bj < 2; ++bj) { const int r = row0 + ai * HALF + m * 16, c = col0 + bj * HALF; b[ai][m][bj] = *(const u32x4*)(hin + (tin ? tiled_off(r, c, ldc) : (size_t)r * ldc + c)); }
#pragma unroll
        for (int ai = 0; ai < 2; ++ai)
#pragma unroll
            for (int m = 0; m < 4; ++m) { float q = 0.f;
#pragma unroll
                for (int bj = 0; bj < 2; ++bj) { f32x4 x0, x1; unpack8(b[ai][m][bj], x0, x1); x0 = x0 + acc[ai][bj][m][0]; x1 = x1 + acc[ai][bj][m][1]; q += sq4(x0) + sq4(x1);
                    const int r = row0 + ai * HALF + m * 16, c = col0 + bj * HALF;
                    *(u32x4*)(hout + (tout ? tiled_off(r, c, ldc) : (size_t)r * ldc + c)) = pack8(x0, x1);
                    if (hf8) { int w0 = 0, w1 = 0; w0 = __builtin_amdgcn_cvt_pk_fp8_f32(x0[0], x0[1], w0, false); w0 = __builtin_amdgcn_cvt_pk_fp8_f32(x0[2], x0[3], w0, true);
                        w1 = __builtin_amdgcn_cvt_pk_fp8_f32(x1[0], x1[1], w1, false); w1 = __builtin_amdgcn_cvt_pk_fp8_f32(x1[2], x1[3], w1, true);
                        u32x2 w; w.x = (unsigned)w0; w.y = (unsigned)w1; *(u32x2*)(hf8 + tiled_off8(r, c, ldc)) = w; } }
                row_sumsq_add(ssq + row0 + ai * HALF + m * 16, q, fq); }
    }
};
struct EpiGate {
    static constexpr bool PERM = true, AFTER_DRAIN = false;
    const bf16_t* hin; bf16_t* hout; const bf16_t* E; const float* rs2; const float* rse; const float* gpost; int ldc; float accscale; float inv_n, eps; bf16_t* Gout;
    struct Grp { u32x4 hb[2], eb[2]; float s2, se; };
    __device__ __forceinline__ void ldg(Grp& g, int grp, int row0, size_t off0) const {
        const int r = (grp >> 2) * HALF + (grp & 3) * 16; g.s2 = accscale / sqrtf(rs2[row0 + r] * inv_n + eps); g.se = 1.0f / sqrtf(rse[row0 + r] * inv_n + eps);
#pragma unroll
        for (int bj = 0; bj < 2; ++bj) { const size_t o2 = off0 + (size_t)r * ldc + bj * HALF; g.hb[bj] = *(const u32x4*)(hin + o2); g.eb[bj] = *(const u32x4*)(E + o2); }
    }
    __device__ __forceinline__ void stg(const Grp& g, const f32x4 (&acc)[2][2][4][2], const f32x4 (&gp)[2][2], int grp, size_t off0) const {
        const int ai = grp >> 2, m = grp & 3;
#pragma unroll
        for (int bj = 0; bj < 2; ++bj) { const size_t o2 = off0 + (size_t)(ai * HALF + m * 16) * ldc + bj * HALF; f32x4 h0, h1, e0, e1; unpack8(g.hb[bj], h0, h1); unpack8(g.eb[bj], e0, e1);
            const f32x4 a0 = acc[ai][bj][m][0] * g.s2, a1 = acc[ai][bj][m][1] * g.s2;
            f32x4 s0, s1;
#pragma unroll
            for (int e = 0; e < 4; ++e) { s0[e] = sigmoidf_(a0[e]); s1[e] = sigmoidf_(a1[e]); h0[e] += s0[e] * (e0[e] * g.se * gp[bj][0][e]); h1[e] += s1[e] * (e1[e] * g.se * gp[bj][1][e]); }
            *(u32x4*)(hout + o2) = pack8(h0, h1); *(u32x4*)(Gout + o2) = pack8(s0, s1); }
    }
    __device__ __forceinline__ void operator()(const f32x4 (&acc)[2][2][4][2], const Unit& u, int wr, int wc, int fr, int fq) const {
        const int row0 = u.pm * BM + wr * 64 + fr, col0 = u.pn * BM + wc * 32 + 8 * fq; const size_t off0 = (size_t)row0 * ldc + col0;
        f32x4 gp[2][2];
#pragma unroll
        for (int bj = 0; bj < 2; ++bj)
#pragma unroll
            for (int n = 0; n < 2; ++n) gp[bj][n] = *(const f32x4*)(gpost + col0 + bj * HALF + n * 4);
        Grp g0;
#pragma unroll
        for (int gi = 0; gi < 8; ++gi) { ldg(g0, gi, row0, off0); stg(g0, acc, gp, gi, off0); }
    }
};

struct EpiGateOnly {
    static constexpr bool PERM = true, AFTER_DRAIN = false;
    unsigned char* Gp; const float* ssq2; int ldc; float accscale, inv_n, eps;
    __device__ __forceinline__ void operator()(const f32x4 (&acc)[2][2][4][2], const Unit& u, int wr, int wc, int fr, int fq) const {
        const int row0 = u.pm * BM + wr * 64 + fr, col0 = u.pn * BM + wc * 32 + 8 * fq;
        float sv[2][4];
#pragma unroll
        for (int ai = 0; ai < 2; ++ai)
#pragma unroll
            for (int m = 0; m < 4; ++m) sv[ai][m] = accscale / sqrtf(ssq2[row0 + ai * HALF + m * 16] * inv_n + eps);
#pragma unroll
        for (int ai = 0; ai < 2; ++ai)
#pragma unroll
            for (int m = 0; m < 4; ++m) { const int row = row0 + ai * HALF + m * 16; const float s = sv[ai][m];
#pragma unroll
                for (int bj = 0; bj < 2; ++bj) { f32x4 v0 = acc[ai][bj][m][0] * s, v1 = acc[ai][bj][m][1] * s;
#pragma unroll
                    for (int e = 0; e < 4; ++e) { v0[e] = sigmoidf_(v0[e]) * 255.0f + 0.5f; v1[e] = sigmoidf_(v1[e]) * 255.0f + 0.5f; }
                    u32x2 w; w.x = (unsigned)v0[0] | ((unsigned)v0[1] << 8) | ((unsigned)v0[2] << 16) | ((unsigned)v0[3] << 24); w.y = (unsigned)v1[0] | ((unsigned)v1[1] << 8) | ((unsigned)v1[2] << 16) | ((unsigned)v1[3] << 24);
                    *(u32x2*)(Gp + (size_t)row * ldc + col0 + bj * HALF) = w; } }
    }
};

template <class Epi, class Sched, bool ALIGN_EPI = false, bool SP2 = false, bool FP8 = false, bool ATILED = false>
__device__ __forceinline__ void gemm_phase(PG8_LAS unsigned char* lds, const Gemm g, const Sched& S, const Epi& E, int wid_in) {
    const int wid = __builtin_amdgcn_readfirstlane(wid_in), lane = hw_lane(), tid = wid * 64 + lane, wr = wid >> 2, wc = wid & 3, fr = lane & 15, fq = lane >> 4;
    const int K = g.K, nt = K / BK;
    unsigned voffA[2], voffB[2];
#pragma unroll
    for (int i = 0; i < 2; ++i) { int R, C; stage_rc(tid * 16 + i * 8192, R, C); const int Rb = Epi::PERM ? ((R & ~31) + perm32(R & 31)) : R;
        voffA[i] = ATILED ? (unsigned)((R >> 4) * (K * 32) + (C >> 5) * 1024 + (R & 15) * 64 + (C & 31) * 2) : (unsigned)(R * K + C) * 2u; voffB[i] = (unsigned)(Rb * K + C) * 2u; }
    const size_t kstep = (size_t)(BK * 2);
    const size_t kstepA = ATILED ? (size_t)2048 : kstep;
    const size_t hstep = (size_t)HALF * K * 2;
    const size_t tstep = 2 * hstep;
    const unsigned ldsw = (unsigned)wid * 1024u, ldsbase = (unsigned)(uintptr_t)lds;
    const int aoff = lds_byte(wr * 64 + fr, fq * 8), boff = lds_byte(wc * 32 + fr, fq * 8);
#define PG8_SA(b, h) (((b) * 2 + (h)) * HTB)
#define PG8_SB(b, h) ((4 + (b) * 2 + (h)) * HTB)
#define PG8_STAGE(bufoff, gbase, voff) do { _Pragma("unroll") for (int _i = 0; _i < 2; ++_i) { unsigned keep_; \
        asm volatile("s_mov_b32 %0, m0\n\ts_mov_b32 m0, %1\n\ts_nop 0\n\tglobal_load_lds_dwordx4 %2, %3\n\ts_mov_b32 m0, %0" \
            : "=&s"(keep_) : "s"(ldsbase + (unsigned)((bufoff) + _i * 8192) + ldsw), "v"((voff)[_i]), "s"((const char*)(gbase)) : "memory"); } } while (0)
#define PG8_LDA(dst, b, h) do { _Pragma("unroll") for (int m = 0; m < 4; ++m) _Pragma("unroll") for (int k = 0; k < 2; ++k) dst[m][k] = *(const PG8_LAS bf16x8*)(lds + PG8_SA(b, h) + aoff + m * 2048 + k * 1024); } while (0)
#define PG8_LDB(dst, b, h) do { _Pragma("unroll") for (int n = 0; n < 2; ++n) _Pragma("unroll") for (int k = 0; k < 2; ++k) dst[n][k] = *(const PG8_LAS bf16x8*)(lds + PG8_SB(b, h) + boff + n * 2048 + k * 1024); } while (0)
#define PG8_MMA(ai, bj, At, Bt) do { __builtin_amdgcn_s_setprio(1); \
        if constexpr (FP8) { _Pragma("unroll") for (int m = 0; m < 4; ++m) _Pragma("unroll") for (int n = 0; n < 2; ++n) { \
            const v8i32 fb_ = __builtin_shufflevector(__builtin_bit_cast(v4i32, Bt[n][0]), __builtin_bit_cast(v4i32, Bt[n][1]), 0, 1, 2, 3, 4, 5, 6, 7), fa_ = __builtin_shufflevector(__builtin_bit_cast(v4i32, At[m][0]), __builtin_bit_cast(v4i32, At[m][1]), 0, 1, 2, 3, 4, 5, 6, 7); \
            acc[ai][bj][m][n] = __builtin_amdgcn_mfma_scale_f32_16x16x128_f8f6f4(fb_, fa_, acc[ai][bj][m][n], 0, 0, 0, 0x7f7f7f7f, 0, 0x7f7f7f7f); } } \
        else { _Pragma("unroll") for (int m = 0; m < 4; ++m) _Pragma("unroll") for (int n = 0; n < 2; ++n) _Pragma("unroll") for (int k = 0; k < 2; ++k) \
            acc[ai][bj][m][n] = __builtin_amdgcn_mfma_f32_16x16x32_bf16(Bt[n][k], At[m][k], acc[ai][bj][m][n], 0, 0, 0); } \
        __builtin_amdgcn_s_setprio(0); } while (0)
#define PG8_WAIT_V(n) asm volatile("s_waitcnt vmcnt(" #n ")" ::: "memory")
#define PG8_WAIT_L(n) asm volatile("s_waitcnt lgkmcnt(" #n ")" ::: "memory")
#define PG8_BAR __builtin_amdgcn_s_barrier()
#define PG8_SCHED __builtin_amdgcn_sched_barrier(0)
    Unit cur, nxt; int ui = 0;
    if (!S.next(0, cur)) return;
    f32x4 acc[2][2][4][2];
#pragma unroll
    for (int a = 0; a < 2; ++a)
#pragma unroll
        for (int b = 0; b < 2; ++b)
#pragma unroll
            for (int m = 0; m < 4; ++m)
#pragma unroll
                for (int n = 0; n < 2; ++n) acc[a][b][m][n] = (f32x4){0.f, 0.f, 0.f, 0.f};
    bf16x8 At[4][2], B0[2][2], B1[2][2];
    const char* cA = (const char*)g.A + (size_t)cur.pm * tstep; const char* cB = (const char*)g.Bt + (size_t)cur.pn * tstep;
    S.a_ready(cur);
    if constexpr (SP2) {
        PG8_STAGE(PG8_SB(0, 0), cB, voffB); PG8_STAGE(PG8_SB(0, 1), cB + hstep, voffB); PG8_STAGE(PG8_SA(0, 0), cA, voffA); PG8_STAGE(PG8_SA(0, 1), cA + hstep, voffA);
        if (wr == 1) PG8_BAR;
        PG8_WAIT_V(2); PG8_BAR;
        PG8_STAGE(PG8_SB(1, 0), cB + kstep, voffB); PG8_STAGE(PG8_SA(1, 0), cA + kstepA, voffA); PG8_STAGE(PG8_SB(1, 1), cB + hstep + kstep, voffB);
        PG8_WAIT_V(6); PG8_BAR;
    } else {
        PG8_STAGE(PG8_SB(0, 0), cB, voffB); PG8_STAGE(PG8_SA(0, 0), cA, voffA); PG8_STAGE(PG8_SB(0, 1), cB + hstep, voffB); PG8_STAGE(PG8_SA(0, 1), cA + hstep, voffA);
        if (wr == 1) PG8_BAR;
        PG8_WAIT_V(4); PG8_BAR;
        PG8_STAGE(PG8_SB(1, 0), cB + kstep, voffB); PG8_STAGE(PG8_SA(1, 0), cA + kstepA, voffA); PG8_STAGE(PG8_SB(1, 1), cB + hstep + kstep, voffB);
        PG8_WAIT_V(6); PG8_BAR;
    }
    for (;;) {
        const bool has_next = S.next(ui + 1, nxt);
        const char* nA = has_next ? (const char*)g.A + (size_t)nxt.pm * tstep : cA; const char* nB = has_next ? (const char*)g.Bt + (size_t)nxt.pn * tstep : cB;
        for (int t = 0; t < nt; t += 2) {
            const bool last = (t == nt - 2);
            const char* a1 = cA + (size_t)(t + 1) * kstepA;
            const char* a2 = last ? nA : cA + (size_t)(t + 2) * kstepA; const char* b2 = last ? nB : cB + (size_t)(t + 2) * kstep;
            const char* a3 = a2 + kstepA; const char* b3 = b2 + kstep;
            if (last && has_next) S.a_ready(nxt);
            if constexpr (SP2) {
            PG8_LDB(B0, 0, 0); PG8_LDB(B1, 0, 1); PG8_SCHED; PG8_LDA(At, 0, 0); PG8_STAGE(PG8_SA(1, 1), a1 + hstep, voffA);
            PG8_WAIT_V(8); PG8_WAIT_L(0); PG8_BAR; PG8_MMA(0, 0, At, B0); PG8_MMA(0, 1, At, B1); PG8_BAR; PG8_SCHED;
            PG8_LDA(At, 0, 1); PG8_STAGE(PG8_SB(0, 0), b2, voffB); PG8_STAGE(PG8_SB(0, 1), b2 + hstep, voffB); PG8_STAGE(PG8_SA(0, 0), a2, voffA);
            PG8_WAIT_V(8); PG8_WAIT_L(0); PG8_BAR; PG8_MMA(1, 0, At, B0); PG8_MMA(1, 1, At, B1); PG8_BAR; PG8_SCHED;
            PG8_LDB(B0, 1, 0); PG8_LDB(B1, 1, 1); PG8_SCHED; PG8_LDA(At, 1, 0); PG8_STAGE(PG8_SA(0, 1), a2 + hstep, voffA);
            PG8_WAIT_V(8); PG8_WAIT_L(0); PG8_BAR; PG8_MMA(0, 0, At, B0); PG8_MMA(0, 1, At, B1); PG8_BAR; PG8_SCHED;
            PG8_LDA(At, 1, 1); PG8_STAGE(PG8_SB(1, 0), b3, voffB); PG8_STAGE(PG8_SB(1, 1), b3 + hstep, voffB); PG8_STAGE(PG8_SA(1, 0), a3, voffA);
            PG8_WAIT_V(8); PG8_WAIT_L(0); PG8_BAR; PG8_MMA(1, 0, At, B0); PG8_MMA(1, 1, At, B1); PG8_BAR; PG8_SCHED;
            } else {
            PG8_LDB(B0, 0, 0); PG8_SCHED; PG8_LDA(At, 0, 0); PG8_STAGE(PG8_SA(1, 1), a1 + hstep, voffA);
            PG8_WAIT_L(8); PG8_BAR; PG8_WAIT_L(0); PG8_MMA(0, 0, At, B0); PG8_BAR; PG8_SCHED;
            PG8_LDB(B1, 0, 1); PG8_STAGE(PG8_SB(0, 0), b2, voffB);
            PG8_BAR; PG8_WAIT_L(0); PG8_MMA(0, 1, At, B1); PG8_BAR;
            PG8_LDA(At, 0, 1); PG8_STAGE(PG8_SA(0, 0), a2, voffA);
            PG8_BAR; PG8_WAIT_L(0); PG8_MMA(1, 0, At, B0); PG8_BAR; PG8_SCHED;
            PG8_STAGE(PG8_SB(0, 1), b2 + hstep, voffB);
            PG8_WAIT_V(6); PG8_BAR; PG8_MMA(1, 1, At, B1); PG8_BAR;
            PG8_LDB(B0, 1, 0); PG8_SCHED; PG8_LDA(At, 1, 0); PG8_STAGE(PG8_SA(0, 1), a2 + hstep, voffA);
            PG8_WAIT_L(8); PG8_BAR; PG8_WAIT_L(0); PG8_MMA(0, 0, At, B0); PG8_BAR; PG8_SCHED;
            PG8_LDB(B1, 1, 1); PG8_STAGE(PG8_SB(1, 0), b3, voffB);
            PG8_BAR; PG8_WAIT_L(0); PG8_MMA(0, 1, At, B1); PG8_BAR;
            PG8_LDA(At, 1, 1); PG8_STAGE(PG8_SA(1, 0), a3, voffA);
            PG8_BAR; PG8_WAIT_L(0); PG8_MMA(1, 0, At, B0); PG8_BAR; PG8_SCHED;
            PG8_STAGE(PG8_SB(1, 1), b3 + hstep, voffB);
            PG8_WAIT_V(6); PG8_BAR; PG8_MMA(1, 1, At, B1); PG8_BAR;
            }
        }
        if constexpr (ALIGN_EPI) { if (wr == 0) PG8_BAR; }
        if constexpr (!Epi::AFTER_DRAIN) { const int le_ = hw_lane(); E(acc, cur, wr, wc, le_ & 15, le_ >> 4); S.done(cur); }
        if (!has_next) break;
#pragma unroll
        for (int a = 0; a < 2; ++a)
#pragma unroll
            for (int b = 0; b < 2; ++b)
#pragma unroll
                for (int m = 0; m < 4; ++m)
#pragma unroll
                    for (int n = 0; n < 2; ++n) acc[a][b][m][n] = (f32x4){0.f, 0.f, 0.f, 0.f};
        cur = nxt; cA = nA; cB = nB; ++ui;
        if constexpr (ALIGN_EPI) { if (wr == 1) PG8_BAR; }
    }
    PG8_WAIT_V(0);
    if constexpr (!ALIGN_EPI) { if (wr == 0) PG8_BAR; }
    PG8_BAR;
    if constexpr (Epi::AFTER_DRAIN) { E.fused(acc, cur, wr, wc, fr, fq, lds, wid, lane); S.done(cur); }
#undef PG8_SA
#undef PG8_SB
#undef PG8_STAGE
#undef PG8_LDA
#undef PG8_LDB
#undef PG8_MMA
#undef PG8_WAIT_V
#undef PG8_WAIT_L
#undef PG8_BAR
#undef PG8_SCHED
}
}
namespace att {
#define ALAS __attribute__((address_space(3)))
typedef unsigned short bf16_t;
typedef short bf16x8 __attribute__((ext_vector_type(8)));
typedef short s16x4 __attribute__((ext_vector_type(4)));
typedef float f32x16 __attribute__((ext_vector_type(16)));
typedef float f32x4 __attribute__((ext_vector_type(4)));
typedef unsigned u32x4 __attribute__((ext_vector_type(4)));
constexpr int SEQ = 4096, NH = 16, QKD = 192, VD = 128, QPITCH = NH * QKD  , KVPITCH = NH * 256  , OPITCH = 4096;
constexpr int SHM_V = 64 * 256, SHM_K = 64 * 384;
constexpr int OFF_V = 0, OFF_K = 3 * SHM_V, OFF_WS = 3 * SHM_V + 3 * SHM_K, LDS_BYTES = OFF_WS + 8 * 64 * 4;
#define KSWZ(row, colB) ((row) * 384 + ((colB) ^ ((((row) >> 1) & 7) << 4)))
#define SBAR() __builtin_amdgcn_sched_barrier(0)
__device__ __forceinline__ int v_st(int k, int c) { const int kk = (k & ~0xC) | ((k & 4) << 1) | ((k & 8) >> 1); return ((kk >> 3) * 4 + (c >> 5)) * 512 + ((kk & 7) * 32 + (c & 31)) * 2; }
__device__ __forceinline__ int v_rd_base(int lane) { return ((lane & 3) << 3) | (((lane >> 2) & 3) << 6) | (((lane >> 4) & 1) << 5) | (((lane >> 5) & 1) << 8); }
constexpr int v_rd_off(int d0, int ks, int half) { return d0 * 512 + ks * 4096 + half * 2048; }
__device__ __forceinline__ int crow(int r, int hi) { return (r & 3) + 8 * (r >> 2) + 4 * hi; }
__device__ __forceinline__ unsigned cvtpk(float lo, float hi) { unsigned r; asm volatile("s_nop 0\n\tv_cvt_pk_bf16_f32 %0, %1, %2" : "=v"(r) : "v"(lo), "v"(hi)); return r; }
__device__ __forceinline__ float bflo(unsigned w) { return __uint_as_float(w << 16); }
__device__ __forceinline__ float bfhi(unsigned w) { return __uint_as_float(w & 0xffff0000u); }

__device__ __forceinline__ void qkt(f32x16& p0, f32x16& p1, ALAS const char* Kt, int r32, int hi, const bf16x8* qr) {
    p0 = f32x16{}; p1 = f32x16{};
    ALAS const char* kb[4];
#pragma unroll
    for (int dd = 0; dd < 4; ++dd) kb[dd] = Kt + KSWZ(r32, (dd * 16 + hi * 8) * 2);
    bf16x8 kf[2][4];
#define KLD(bi_, sl_) do { _Pragma("unroll") for (int e_ = 0; e_ < 2; ++e_) { const int d0_ = 2 * (bi_) + e_; ALAS const char* a_ = kb[d0_ & 3] + (d0_ >> 2) * 128; \
        kf[sl_][2 * e_] = *(ALAS const bf16x8*)a_; kf[sl_][2 * e_ + 1] = *(ALAS const bf16x8*)(a_ + 32 * 384); } } while (0)
    KLD(0, 0);
#pragma unroll
    for (int bi = 0; bi < 6; ++bi) {
        if (bi < 5) KLD(bi + 1, (bi + 1) & 1);
        SBAR(); __builtin_amdgcn_s_setprio(1);
#pragma unroll
        for (int e = 0; e < 2; ++e) { const int d0 = 2 * bi + e;
            p0 = __builtin_amdgcn_mfma_f32_32x32x16_bf16(kf[bi & 1][2 * e], qr[d0], p0, 0, 0, 0);
            p1 = __builtin_amdgcn_mfma_f32_32x32x16_bf16(kf[bi & 1][2 * e + 1], qr[d0], p1, 0, 0, 0); }
        __builtin_amdgcn_s_setprio(0); SBAR();
    }
#undef KLD
}
__device__ __forceinline__ void pv_tile(f32x16* o, int vb, bf16x8 pa0, bf16x8 pa1, bf16x8 pa2, bf16x8 pa3) {
#define TRRD(dst, off) asm volatile("ds_read_b64_tr_b16 %0, %1 offset:%2" : "=&v"(dst) : "v"(vb), "i"(off) : "memory")
#define PV_D0(d0) do { s16x4 l0, l1, l2, l3, h0, h1, h2, h3; constexpr int b_ = v_rd_off(d0, 0, 0); \
        TRRD(l0, b_); TRRD(h0, b_ + 2048); TRRD(l1, b_ + 4096); TRRD(h1, b_ + 6144); TRRD(l2, b_ + 8192); TRRD(h2, b_ + 10240); TRRD(l3, b_ + 12288); TRRD(h3, b_ + 14336); \
        asm volatile("s_waitcnt lgkmcnt(0)" ::: "memory"); SBAR(); __builtin_amdgcn_s_setprio(1); \
        o[d0] = __builtin_amdgcn_mfma_f32_32x32x16_bf16(pa0, (bf16x8){l0[0], l0[1], l0[2], l0[3], h0[0], h0[1], h0[2], h0[3]}, o[d0], 0, 0, 0); \
        o[d0] = __builtin_amdgcn_mfma_f32_32x32x16_bf16(pa1, (bf16x8){l1[0], l1[1], l1[2], l1[3], h1[0], h1[1], h1[2], h1[3]}, o[d0], 0, 0, 0); \
        o[d0] = __builtin_amdgcn_mfma_f32_32x32x16_bf16(pa2, (bf16x8){l2[0], l2[1], l2[2], l2[3], h2[0], h2[1], h2[2], h2[3]}, o[d0], 0, 0, 0); \
        o[d0] = __builtin_amdgcn_mfma_f32_32x32x16_bf16(pa3, (bf16x8){l3[0], l3[1], l3[2], l3[3], h3[0], h3[1], h3[2], h3[3]}, o[d0], 0, 0, 0); __builtin_amdgcn_s_setprio(0); } while (0)
    PV_D0(0); PV_D0(1); PV_D0(2); PV_D0(3);
#undef PV_D0
#undef TRRD
}
struct Tensors { const bf16_t* Q; const bf16_t* KV; const bf16_t* KR; const float* RC; const float* RS; bf16_t* O; };
__device__ __forceinline__ void unit(const Tensors& T, int bh, int qb, ALAS char* lds, int wid_in) {
    const int wid = __builtin_amdgcn_readfirstlane(wid_in), lane = hw_lane(), tid = wid * 64 + lane, r32 = lane & 31, hi = lane >> 5;
    const int b = bh >> 4, h = bh & 15; const size_t rowbase = (size_t)b * SEQ; const int q0 = qb * 256, NT = 4 * (qb + 1);
    ALAS char* V_lds = lds + OFF_V; ALAS char* K_lds = lds + OFF_K;
    ALAS float* ws = (ALAS float*)(lds + OFF_WS) + wid * 64; ALAS float* li_l = ws; ALAS float* al_l = ws + 32;
    const size_t qrow = rowbase + q0 + wid * 32 + r32;
    const bf16_t* Qw = T.Q + qrow * QPITCH + h * QKD + hi * 8;
    bf16x8 qr[12];
#pragma unroll
    for (int d0 = 0; d0 < 12; ++d0) qr[d0] = *(const bf16x8*)(Qw + d0 * 16);
#pragma unroll
    for (int p = 0; p < 2; ++p) { const float* cp = T.RC + qrow * 32 + 16 * p + 8 * hi; const float* sp = T.RS + qrow * 32 + 16 * p + 8 * hi;
        const f32x4 c0 = *(const f32x4*)cp, c1 = *(const f32x4*)(cp + 4), s0 = *(const f32x4*)sp, s1 = *(const f32x4*)(sp + 4);
        const u32x4 a = __builtin_bit_cast(u32x4, qr[8 + p]), bb = __builtin_bit_cast(u32x4, qr[10 + p]); u32x4 na, nb;
#pragma unroll
        for (int w = 0; w < 4; ++w) { const float cl = w < 2 ? c0[2 * w] : c1[2 * w - 4], ch = w < 2 ? c0[2 * w + 1] : c1[2 * w - 3], sl = w < 2 ? s0[2 * w] : s1[2 * w - 4], sh = w < 2 ? s0[2 * w + 1] : s1[2 * w - 3];
            const float x1l = bflo(a[w]), x1h = bfhi(a[w]), x2l = bflo(bb[w]), x2h = bfhi(bb[w]);
            na[w] = cvtpk(x1l * cl - x2l * sl, x1h * ch - x2h * sh); nb[w] = cvtpk(x2l * cl + x1l * sl, x2h * ch + x1h * sh); }
        qr[8 + p] = __builtin_bit_cast(bf16x8, na); qr[10 + p] = __builtin_bit_cast(bf16x8, nb); }
    const char* KVb = (const char*)T.KV; const char* KRb = (const char*)T.KR;
    unsigned koff[3]; unsigned krope = 0u;
#pragma unroll
    for (int i = 0; i < 3; ++i) { const int ci = (wid + 8 * i) * 64 + lane, row = ci / 24, sl = ci - row * 24, c = ((sl & 7) ^ ((row >> 1) & 7)) | (sl & 24);
        const bool rp = c >= 16; if (rp) krope |= (1u << i);
        koff[i] = rp ? (unsigned)(((rowbase + row) * 64 + (c - 16) * 8) * 2) : (unsigned)(((rowbase + row) * KVPITCH + h * 256 + c * 8) * 2); }
    unsigned voff[2];
#pragma unroll
    for (int i = 0; i < 2; ++i) { const int ob = (wid + 8 * i) * 1024 + lane * 16, st = ob >> 9, kk = (st >> 2) * 8 + ((ob & 511) >> 6), c = (st & 3) * 32 + ((ob & 63) >> 1), k = (kk & ~0xC) | ((kk & 4) << 1) | ((kk & 8) >> 1);
        voff[i] = (unsigned)(((rowbase + k) * KVPITCH + h * 256 + 128 + c) * 2); }
    const int vb0 = (int)(unsigned)(uintptr_t)V_lds + v_rd_base(lane);
#define SDMA(t_, ko_, vo_) do { \
        _Pragma("unroll") for (int i_ = 0; i_ < 3; ++i_) { const bool rp_ = (krope >> i_) & 1u; const char* src_ = (rp_ ? KRb : KVb) + (koff[i_] + (unsigned)(t_) * (rp_ ? 8192u : 64u * KVPITCH * 2u)); \
            __builtin_amdgcn_global_load_lds((const unsigned*)src_, (ALAS unsigned*)(K_lds + (ko_) + (wid + 8 * i_) * 1024), 16, 0, 0); } \
        _Pragma("unroll") for (int i_ = 0; i_ < 2; ++i_) { const char* src_ = KVb + (voff[i_] + (unsigned)(t_) * (64u * KVPITCH * 2u)); \
            __builtin_amdgcn_global_load_lds((const unsigned*)src_, (ALAS unsigned*)(V_lds + (vo_) + (wid + 8 * i_) * 1024), 16, 0, 0); } } while (0)
    float m_reg = -1e30f, l_reg = 0.f; f32x16 o[4] = {};
    const int qlo = q0 + wid * 32, qpos = qlo + r32;
    SDMA(0, 0, 0); SDMA(1, SHM_K, SHM_V);
    asm volatile("s_waitcnt vmcnt(5)" ::: "memory"); __builtin_amdgcn_s_barrier(); asm volatile("" ::: "memory");
    f32x16 p0, p1; bf16x8 pa0, pa1, pa2, pa3;
#define PK4(P, B_, OUT) do { unsigned a0 = cvtpk(P[B_ + 0], P[B_ + 1]), a1 = cvtpk(P[B_ + 2], P[B_ + 3]); unsigned b0 = cvtpk(P[B_ + 4], P[B_ + 5]), b1 = cvtpk(P[B_ + 6], P[B_ + 7]); \
        auto r0 = __builtin_amdgcn_permlane32_swap(a0, b0, false, false); auto r1 = __builtin_amdgcn_permlane32_swap(a1, b1, false, false); \
        u32x4 w = {r0[0], r1[0], r0[1], r1[1]}; OUT = __builtin_bit_cast(bf16x8, w); } while (0)
#define QK_SM(tt_, ko_) do { SBAR(); qkt(p0, p1, K_lds + (ko_), r32, hi, qr); \
        { const int kb_ = (tt_) * 64; if (kb_ + 63 > qlo) { const int dq = qpos - kb_ - 4 * hi; const float NEG = -__builtin_inff(); \
            _Pragma("unroll") for (int r = 0; r < 16; ++r) { const int c = (r & 3) + 8 * (r >> 2); if (c > dq) p0[r] = NEG; if (c + 32 > dq) p1[r] = NEG; } } } \
        float pmax = p0[0]; _Pragma("unroll") for (int r = 1; r < 16; ++r) pmax = fmaxf(pmax, p0[r]); _Pragma("unroll") for (int r = 0; r < 16; ++r) pmax = fmaxf(pmax, p1[r]); \
        { auto rr_ = __builtin_amdgcn_permlane32_swap(__float_as_uint(pmax), __float_as_uint(pmax), false, false); pmax = fmaxf(__uint_as_float(rr_[0]), __uint_as_float(rr_[1])); } \
        float alpha = 1.f; \
        if (!__all(pmax - m_reg <= 8.0f)) { const float mn = fmaxf(m_reg, pmax); alpha = __builtin_amdgcn_exp2f(m_reg - mn); m_reg = mn;     \
            if (hi == 0) al_l[r32] = alpha; asm volatile("s_waitcnt lgkmcnt(0)" ::: "memory"); \
            _Pragma("unroll") for (int d_ = 0; d_ < 4; ++d_) _Pragma("unroll") for (int r = 0; r < 16; ++r) o[d_][r] *= al_l[crow(r, hi)]; } \
        _Pragma("unroll") for (int r = 0; r < 16; ++r) { p0[r] = __builtin_amdgcn_exp2f(p0[r] - m_reg); p1[r] = __builtin_amdgcn_exp2f(p1[r] - m_reg); } \
        float ps = 0.f; _Pragma("unroll") for (int r = 0; r < 16; ++r) ps += p0[r]; _Pragma("unroll") for (int r = 0; r < 16; ++r) ps += p1[r]; \
        { auto rr_ = __builtin_amdgcn_permlane32_swap(__float_as_uint(ps), __float_as_uint(ps), false, false); ps = __uint_as_float(rr_[0]) + __uint_as_float(rr_[1]); } \
        l_reg = l_reg * alpha + ps; \
        PK4(p0, 0, pa0); PK4(p0, 8, pa1); PK4(p1, 0, pa2); PK4(p1, 8, pa3); SBAR(); } while (0)
    int ko = 0, vo = 0, kn2 = 2 * SHM_K, vn2 = 2 * SHM_V;
    for (int t = 0; t < NT; ++t) { const bool more2 = t + 2 < NT;
        if (more2) SDMA(t + 2, kn2, vn2);
        if (t * 64 <= qlo + 31) {
            QK_SM(t, ko);
            pv_tile(o, vb0 + vo, pa0, pa1, pa2, pa3); }
        asm volatile("s_waitcnt lgkmcnt(0)" ::: "memory");
        if (more2) asm volatile("s_waitcnt vmcnt(5)" ::: "memory"); else asm volatile("s_waitcnt vmcnt(0)" ::: "memory");
        __builtin_amdgcn_s_barrier(); asm volatile("" ::: "memory");
        kn2 = ko; vn2 = vo;
        ko = (ko == 2 * SHM_K) ? 0 : ko + SHM_K; vo = (vo == 2 * SHM_V) ? 0 : vo + SHM_V; }
#undef PK4
#undef QK_SM
#undef SDMA
    if (hi == 0) li_l[r32] = l_reg; asm volatile("s_waitcnt lgkmcnt(0)" ::: "memory");
    float rli[16];
#pragma unroll
    for (int r = 0; r < 16; ++r) rli[r] = __builtin_amdgcn_rcpf(li_l[crow(r, hi)]);
    bf16_t* Ow = T.O + (rowbase + q0 + wid * 32) * OPITCH + h * VD;
    ALAS char* stg = K_lds + wid * (32 * 272);
#pragma unroll
    for (int r = 0; r < 16; ++r) { const int orow = crow(r, hi);
#pragma unroll
        for (int d0 = 0; d0 < 4; ++d0) { const float v = o[d0][r] * rli[r]; const float vn = __int_as_float(__builtin_amdgcn_mov_dpp(__float_as_int(v), 0xB1  , 0xF, 0xF, true));
            if ((r32 & 1) == 0) *(ALAS unsigned*)(stg + orow * 272 + (d0 * 32 + r32) * 2) = cvtpk(v, vn); } }
    asm volatile("s_waitcnt lgkmcnt(0)" ::: "memory");
#pragma unroll
    for (int j = 0; j < 8; ++j) { const int idx = j * 64 + lane, row = idx >> 4, ch = idx & 15; const u32x4 w = *(ALAS const u32x4*)(stg + row * 272 + ch * 16);
        *(u32x4*)(Ow + (size_t)row * OPITCH + ch * 8) = w; }
    __syncthreads();
}
#undef SBAR
}
namespace hg {
#define HLAS __attribute__((address_space(3)))
#define HGAS __attribute__((address_space(1)))
#define HG_SYNC() do { asm volatile("s_waitcnt lgkmcnt(0)" ::: "memory"); __builtin_amdgcn_s_barrier(); asm volatile("" ::: "memory"); } while (0)
typedef unsigned short bf16_t;
typedef short bf16x8 __attribute__((ext_vector_type(8)));
typedef short s16x4 __attribute__((ext_vector_type(4)));
typedef float f32x16 __attribute__((ext_vector_type(16)));
typedef float f32x4 __attribute__((ext_vector_type(4)));
typedef unsigned u32x4 __attribute__((ext_vector_type(4)));
typedef unsigned u32x2 __attribute__((ext_vector_type(2)));
constexpr int SEQ = 4096, HGD = 2048, NCH = 64  , NUNIT = 4 * 16 * NCH;
__device__ __forceinline__ unsigned cvtpk(float lo, float hi) { unsigned r; asm volatile("s_nop 0\n\tv_cvt_pk_bf16_f32 %0, %1, %2" : "=v"(r) : "v"(lo), "v"(hi)); return r; }
__device__ __forceinline__ float bflo(unsigned w) { return __uint_as_float(w << 16); }
__device__ __forceinline__ float bfhi(unsigned w) { return __uint_as_float(w & 0xffff0000u); }

constexpr int P1_V = 0, P1_K = 16384, P1_GT = 32768;
struct P1In { u32x2 kw[4]; u32x4 v0, v1; };
__device__ __forceinline__ void pass1_load(P1In& I, const bf16_t* KF, const bf16_t* VH, int unit, int tid) {
    const int bh = unit >> 6, c = unit & 63, b = bh >> 4, h = bh & 15; const size_t row0 = (size_t)b * SEQ + 64 * c;
    const int cq = tid & 31, tg = tid >> 5;
#pragma unroll
    for (int i = 0; i < 4; ++i) I.kw[i] = *(const HGAS u32x2*)(KF + (row0 + 4 * tg + i) * HGD + h * 128 + 4 * cq);
    const int sr = tid >> 4, sc = tid & 15; const bf16_t* vp = VH + (row0 + sr) * HGD + h * 128 + sc * 8;
    I.v0 = *(const HGAS u32x4*)vp; I.v1 = *(const HGAS u32x4*)(vp + 32 * HGD);
}
__device__ __forceinline__ void pass1_compute(const P1In& I, bf16_t* UT, float* DD, int unit, HLAS char* lds, int wid, int lane) {
    const int tid = wid * 64 + lane;
    const int cq = tid & 31, tg = tid >> 5;
    f32x4 f[4];
#pragma unroll
    for (int i = 0; i < 4; ++i) f[i] = (f32x4){1.f - bflo(I.kw[i].x), 1.f - bfhi(I.kw[i].x), 1.f - bflo(I.kw[i].y), 1.f - bfhi(I.kw[i].y)};
    { const int sr = tid >> 4, sc = tid & 15;
      *(HLAS u32x4*)(lds + P1_V + att::v_st(sr, sc * 8)) = I.v0; *(HLAS u32x4*)(lds + P1_V + att::v_st(32 + sr, sc * 8)) = I.v1; }
    f32x4 suf[4]; suf[3] = (f32x4){1.f, 1.f, 1.f, 1.f}; suf[2] = f[3]; suf[1] = f[3] * f[2]; suf[0] = suf[1] * f[1];
    const f32x4 gt = suf[0] * f[0];
    HLAS f32x4* GT = (HLAS f32x4*)(lds + P1_GT);
    GT[tg * 32 + cq] = gt;
    HG_SYNC();
    f32x4 lp = (f32x4){1.f, 1.f, 1.f, 1.f};
#pragma unroll
    for (int i = 1; i < 16; ++i) { const f32x4 g = GT[i * 32 + cq]; if (i > tg) lp = lp * g; }
    if (tg == 0) *(HGAS f32x4*)(DD + (size_t)unit * 128 + 4 * cq) = lp * gt;
#pragma unroll
    for (int i = 0; i < 4; ++i) { const f32x4 kt = ((f32x4){1.f, 1.f, 1.f, 1.f} - f[i]) * suf[i] * lp;
        u32x2 w; w.x = cvtpk(kt.x, kt.y); w.y = cvtpk(kt.z, kt.w); *(HLAS u32x2*)(lds + P1_K + att::v_st(4 * tg + i, 4 * cq)) = w; }
    HG_SYNC();
    const int vt = wid >> 1, kt0 = 2 * (wid & 1);
    const int vbV = (int)(unsigned)(uintptr_t)(lds + P1_V) + att::v_rd_base(lane), vbK = (int)(unsigned)(uintptr_t)(lds + P1_K) + att::v_rd_base(lane);
    f32x16 acc0 = {}, acc1 = {};
#define HTR(dst, base, off) asm volatile("ds_read_b64_tr_b16 %0, %1 offset:%2" : "=&v"(dst) : "v"(base), "i"(off) : "memory")
#pragma unroll
    for (int ks = 0; ks < 4; ++ks) { s16x4 al, ah, b0l, b0h, b1l, b1h;
        const int oa = vt * 512 + ks * 4096, ob = kt0 * 512 + ks * 4096;
        asm volatile("ds_read_b64_tr_b16 %0, %1" : "=&v"(al) : "v"(vbV + oa) : "memory"); asm volatile("ds_read_b64_tr_b16 %0, %1" : "=&v"(ah) : "v"(vbV + oa + 2048) : "memory");
        asm volatile("ds_read_b64_tr_b16 %0, %1" : "=&v"(b0l) : "v"(vbK + ob) : "memory"); asm volatile("ds_read_b64_tr_b16 %0, %1" : "=&v"(b0h) : "v"(vbK + ob + 2048) : "memory");
        asm volatile("ds_read_b64_tr_b16 %0, %1" : "=&v"(b1l) : "v"(vbK + ob + 512) : "memory"); asm volatile("ds_read_b64_tr_b16 %0, %1" : "=&v"(b1h) : "v"(vbK + ob + 512 + 2048) : "memory");
        asm volatile("s_waitcnt lgkmcnt(0)" ::: "memory"); __builtin_amdgcn_sched_barrier(0);
        const bf16x8 a = {al[0], al[1], al[2], al[3], ah[0], ah[1], ah[2], ah[3]}, b0 = {b0l[0], b0l[1], b0l[2], b0l[3], b0h[0], b0h[1], b0h[2], b0h[3]}, b1 = {b1l[0], b1l[1], b1l[2], b1l[3], b1h[0], b1h[1], b1h[2], b1h[3]};
        acc0 = __builtin_amdgcn_mfma_f32_32x32x16_bf16(a, b0, acc0, 0, 0, 0); acc1 = __builtin_amdgcn_mfma_f32_32x32x16_bf16(a, b1, acc1, 0, 0, 0); }
#undef HTR
    { const int r32 = lane & 31, hi = lane >> 5; HLAS char* stg = lds + 40960 + wid * (32 * 144);
#pragma unroll
      for (int r = 0; r < 16; ++r) { const int vrow = att::crow(r, hi); const float a0 = acc0[r], a1 = acc1[r];
          const float n0 = __int_as_float(__builtin_amdgcn_mov_dpp(__float_as_int(a0), 0xB1, 0xF, 0xF, true)), n1 = __int_as_float(__builtin_amdgcn_mov_dpp(__float_as_int(a1), 0xB1, 0xF, 0xF, true));
          if ((r32 & 1) == 0) { *(HLAS unsigned*)(stg + vrow * 144 + r32 * 2) = cvtpk(a0, n0); *(HLAS unsigned*)(stg + vrow * 144 + (32 + r32) * 2) = cvtpk(a1, n1); } }
      asm volatile("s_waitcnt lgkmcnt(0)" ::: "memory");
      bf16_t* up = UT + (size_t)unit * 16384 + (size_t)(32 * vt) * 128 + 32 * kt0;
#pragma unroll
      for (int j = 0; j < 4; ++j) { const int idx = j * 64 + lane, row = idx >> 3, ch = idx & 7; const u32x4 w = *(HLAS const u32x4*)(stg + row * 144 + ch * 16);
          *(HGAS u32x4*)(up + (size_t)row * 128 + ch * 8) = w; } }
    HG_SYNC();
}
__device__ __forceinline__ void pass1_all(const bf16_t* KF, const bf16_t* VH, bf16_t* UT, float* DD, int u0, int ustride, HLAS char* lds, int wid_in) {
    const int wid = __builtin_amdgcn_readfirstlane(wid_in), lane = hw_lane(), tid = wid * 64 + lane;
    P1In A, B;
    int u = u0;
    if (u < NUNIT) pass1_load(A, KF, VH, u, tid);
    while (u < NUNIT) {
        const int u2 = u + ustride, u3 = u2 + ustride;
        if (u2 < NUNIT) pass1_load(B, KF, VH, u2, tid);
        pass1_compute(A, UT, DD, u, lds, wid, lane);
        if (u2 >= NUNIT) break;
        if (u3 < NUNIT) pass1_load(A, KF, VH, u3, tid);
        pass1_compute(B, UT, DD, u2, lds, wid, lane);
        u = u3;
    }
}

__device__ __forceinline__ void pass2_scan(bf16_t* UT, const float* DD, int gt, int NGT) {
    for (int idx = gt; idx < 64 * 2048; idx += NGT) {
        const int bh = idx >> 11, rem = idx & 2047, v = rem >> 4, ko = rem & 15;
        bf16_t* up = UT + (size_t)bh * NCH * 16384 + (size_t)v * 128 + 8 * ko; const float* dp = DD + (size_t)bh * NCH * 128 + 8 * ko;
        float S[8] = {0.f, 0.f, 0.f, 0.f, 0.f, 0.f, 0.f, 0.f};
        for (int c0 = 0; c0 < NCH; c0 += 8) {
            u32x4 u[8]; f32x4 d0[8], d1[8];
#pragma unroll
            for (int i = 0; i < 8; ++i) { u[i] = *(const HGAS u32x4*)(up + (size_t)(c0 + i) * 16384); d0[i] = *(const HGAS f32x4*)(dp + (size_t)(c0 + i) * 128); d1[i] = *(const HGAS f32x4*)(dp + (size_t)(c0 + i) * 128 + 4); }
#pragma unroll
            for (int i = 0; i < 8; ++i) {
                u32x4 o; o.x = cvtpk(S[0], S[1]); o.y = cvtpk(S[2], S[3]); o.z = cvtpk(S[4], S[5]); o.w = cvtpk(S[6], S[7]);
                *(HGAS u32x4*)(up + (size_t)(c0 + i) * 16384) = o;
                S[0] = d0[i].x * S[0] + bflo(u[i].x); S[1] = d0[i].y * S[1] + bfhi(u[i].x); S[2] = d0[i].z * S[2] + bflo(u[i].y); S[3] = d0[i].w * S[3] + bfhi(u[i].y);
                S[4] = d1[i].x * S[4] + bflo(u[i].z); S[5] = d1[i].y * S[5] + bfhi(u[i].z); S[6] = d1[i].z * S[6] + bflo(u[i].w); S[7] = d1[i].w * S[7] + bfhi(u[i].w); }
        }
    }
}

constexpr int RSQ = 272, RSV = 288;
constexpr int P3_QH = 0, P3_QT = 64 * RSQ, P3_W = 128 * RSQ, P3_V = 288 * RSQ, P3_GT = P3_V + 64 * RSV, P3_SS = P3_GT + 8192, P3_END = P3_SS + 512;
static_assert(P3_END <= 131072, "pass-3 LDS");
constexpr int P3_S0 = P3_END, P3_S1 = 131072 + 1024;
static_assert(P3_S0 + 16384 <= 131072, "pass-3 state stage");
__device__ __forceinline__ void pass3_sdma(const bf16_t* ST, int unit, HLAS char* lds, int wid, int lane) {
    const char* sb = (const char*)ST + (size_t)unit * 32768;
#pragma unroll
    for (int i = 0; i < 4; ++i) { const int p = wid + 8 * i, r = 4 * p + (lane >> 4), c = (lane & 15) ^ (r & 15);
        __builtin_amdgcn_global_load_lds((const unsigned*)(sb + r * 256 + c * 16), (HLAS unsigned*)(lds + (i < 2 ? P3_S0 + 1024 * p : P3_S1 + 1024 * (p - 16))), 16, 0, 0); }
    __builtin_amdgcn_sched_barrier(0);
}
__device__ __forceinline__ int wbase(int J) { return J == 0 ? 0 : J == 1 ? 16 : J == 2 ? 48 : 96; }
struct P3In { u32x2 kw[4]; u32x2 qw[4]; u32x4 v0, v1; };
__device__ __forceinline__ void pass3_load(P3In& I, const bf16_t* KF, const bf16_t* QH, const bf16_t* VH, int unit, int tid) {
    const int bh = unit >> 6, c = unit & 63, b = bh >> 4, h = bh & 15; const size_t row0 = (size_t)b * SEQ + 64 * c;
    const int cq = tid & 31, tg = tid >> 5;
#pragma unroll
    for (int i = 0; i < 4; ++i) { I.kw[i] = *(const HGAS u32x2*)(KF + (row0 + 4 * tg + i) * HGD + h * 128 + 4 * cq); I.qw[i] = *(const HGAS u32x2*)(QH + (row0 + 4 * tg + i) * HGD + h * 128 + 4 * cq); }
    const int sr = tid >> 4, sc = tid & 15; const bf16_t* vp = VH + (row0 + sr) * HGD + h * 128 + sc * 8;
    I.v0 = *(const HGAS u32x4*)vp; I.v1 = *(const HGAS u32x4*)(vp + 32 * HGD);
}
__device__ __forceinline__ void pass3_compute(const P3In& I, const bf16_t* GH, const bf16_t* ST, const float* gout, bf16_t* MIX, int unit, int next_unit  , bool prefetched  , HLAS char* lds, int wid, int lane) {
    const int tid = wid * 64 + lane;
    const int bh = unit >> 6, c = unit & 63, b = bh >> 4, h = bh & 15; const size_t row0 = (size_t)b * SEQ + 64 * c;
    const int cq = tid & 31, tg = tid >> 5, j = tg >> 2, pos = tg & 3;
    const int J = wid >> 1, vh = wid & 1, tl = lane & 15, g = lane >> 4;
    const f32x4 one = (f32x4){1.f, 1.f, 1.f, 1.f};
    bf16x8 sf[4][4]; u32x2 gg[4];
    const size_t orow = row0 + 16 * J + tl;
    { const int sr = tid >> 4, sc = tid & 15; *(HLAS u32x4*)(lds + P3_V + sr * RSV + sc * 16) = I.v0; *(HLAS u32x4*)(lds + P3_V + (32 + sr) * RSV + sc * 16) = I.v1; }
    f32x4 kq[4], f[4];
#pragma unroll
    for (int i = 0; i < 4; ++i) { kq[i] = (f32x4){bflo(I.kw[i].x), bfhi(I.kw[i].x), bflo(I.kw[i].y), bfhi(I.kw[i].y)}; f[i] = one - kq[i]; }
    f32x4 pre[4], suf[4]; pre[0] = f[0]; pre[1] = f[0] * f[1]; pre[2] = pre[1] * f[2]; pre[3] = pre[2] * f[3];
    suf[3] = one; suf[2] = f[3]; suf[1] = f[3] * f[2]; suf[0] = suf[1] * f[1];
    HLAS f32x4* GT = (HLAS f32x4*)(lds + P3_GT);
    GT[tg * 32 + cq] = pre[3];
    HG_SYNC();
    f32x4 T[4], E = one, E2 = one;
#pragma unroll
    for (int qd = 0; qd < 4; ++qd) { f32x4 t = one;
#pragma unroll
        for (int m = 0; m < 4; ++m) { const f32x4 gq = GT[(4 * qd + m) * 32 + cq]; t = t * gq; if (qd == j && m < pos) E = E * gq; if (qd == j && m > pos) E2 = E2 * gq; }
        T[qd] = t; }
    f32x4 H = one;
#pragma unroll
    for (int qd = 0; qd < 3; ++qd) if (qd < j) H = H * T[qd];
    const f32x4 T1 = (j == 0) ? T[1] : (j == 1) ? T[2] : T[3];
    const f32x4 T2 = (j == 0) ? T[2] : T[3];
#pragma unroll
    for (int i = 0; i < 4; ++i) { const int t = 4 * tg + i;
        const f32x4 p = E * pre[i], q = (f32x4){bflo(I.qw[i].x), bfhi(I.qw[i].x), bflo(I.qw[i].y), bfhi(I.qw[i].y)}, kk = kq[i];
        const f32x4 qh = q * p, qt = qh * H;
        f32x4 w0; w0.x = kk.x * __builtin_amdgcn_rcpf(p.x); w0.y = kk.y * __builtin_amdgcn_rcpf(p.y); w0.z = kk.z * __builtin_amdgcn_rcpf(p.z); w0.w = kk.w * __builtin_amdgcn_rcpf(p.w);
        const f32x4 w1 = kk * suf[i] * E2, w2 = w1 * T1, w3 = w2 * T2;
        u32x2 o; o.x = cvtpk(qh.x, qh.y); o.y = cvtpk(qh.z, qh.w); *(HLAS u32x2*)(lds + P3_QH + t * RSQ + cq * 8) = o;
        o.x = cvtpk(qt.x, qt.y); o.y = cvtpk(qt.z, qt.w); *(HLAS u32x2*)(lds + P3_QT + t * RSQ + cq * 8) = o;
        o.x = cvtpk(w0.x, w0.y); o.y = cvtpk(w0.z, w0.w); *(HLAS u32x2*)(lds + P3_W + (wbase(j) + t) * RSQ + cq * 8) = o;
        if (j < 3) { o.x = cvtpk(w1.x, w1.y); o.y = cvtpk(w1.z, w1.w); *(HLAS u32x2*)(lds + P3_W + (wbase(j + 1) + t) * RSQ + cq * 8) = o; }
        if (j < 2) { o.x = cvtpk(w2.x, w2.y); o.y = cvtpk(w2.z, w2.w); *(HLAS u32x2*)(lds + P3_W + (wbase(j + 2) + t) * RSQ + cq * 8) = o; }
        if (j < 1) { o.x = cvtpk(w3.x, w3.y); o.y = cvtpk(w3.z, w3.w); *(HLAS u32x2*)(lds + P3_W + (wbase(j + 3) + t) * RSQ + cq * 8) = o; } }
    if (prefetched) asm volatile("s_waitcnt vmcnt(10)" ::: "memory"); else asm volatile("s_waitcnt vmcnt(0)" ::: "memory");
    HG_SYNC();
    f32x4 gwv[4];
#pragma unroll
    for (int vt = 0; vt < 4; ++vt) { gg[vt] = *(const HGAS u32x2*)(GH + orow * HGD + h * 128 + 64 * vh + 16 * vt + 4 * g); gwv[vt] = *(const HGAS f32x4*)(gout + h * 128 + 64 * vh + 16 * vt + 4 * g); }
    bf16x8 qf[4];
#pragma unroll
    for (int k4 = 0; k4 < 4; ++k4) qf[k4] = *(const HLAS bf16x8*)(lds + P3_QH + (16 * J + tl) * RSQ + (32 * k4 + 8 * g) * 2);
    f32x4 X[4];
#pragma unroll
    for (int i = 0; i < 4; ++i) { X[i] = (f32x4){0.f, 0.f, 0.f, 0.f};
        if (i <= J) {
#pragma unroll
            for (int k4 = 0; k4 < 4; ++k4) { const bf16x8 wf = *(const HLAS bf16x8*)(lds + P3_W + (wbase(J) + 16 * i + tl) * RSQ + (32 * k4 + 8 * g) * 2);
                X[i] = __builtin_amdgcn_mfma_f32_16x16x32_bf16(wf, qf[k4], X[i], 0, 0, 0); }
            if (i == J) {
#pragma unroll
                for (int r = 0; r < 4; ++r) if (4 * g + r > tl) X[i][r] = 0.f; } } }
    bf16x8 Bf[2];
    { u32x4 w; w.x = cvtpk(X[0][0], X[0][1]); w.y = cvtpk(X[0][2], X[0][3]); w.z = cvtpk(X[1][0], X[1][1]); w.w = cvtpk(X[1][2], X[1][3]); Bf[0] = __builtin_bit_cast(bf16x8, w);
      w.x = cvtpk(X[2][0], X[2][1]); w.y = cvtpk(X[2][2], X[2][3]); w.z = cvtpk(X[3][0], X[3][1]); w.w = cvtpk(X[3][2], X[3][3]); Bf[1] = __builtin_bit_cast(bf16x8, w); }
#pragma unroll
    for (int k4 = 0; k4 < 4; ++k4) qf[k4] = *(const HLAS bf16x8*)(lds + P3_QT + (16 * J + tl) * RSQ + (32 * k4 + 8 * g) * 2);
    { HLAS const char* sbase = lds + (vh ? P3_S1 : P3_S0) + tl * 256;
#pragma unroll
      for (int vt = 0; vt < 4; ++vt)
#pragma unroll
          for (int k4 = 0; k4 < 4; ++k4) sf[vt][k4] = *(const HLAS bf16x8*)(sbase + vt * 4096 + (((4 * k4 + g) ^ tl) & 15) * 16); }
    f32x4 O[4]; float ss = 0.f;
    const int vtr = (int)(unsigned)(uintptr_t)(lds + P3_V) + (4 * g + (tl >> 2)) * RSV + (64 * vh + 4 * (lane & 3)) * 2;
#pragma unroll
    for (int vt = 0; vt < 4; ++vt) { O[vt] = (f32x4){0.f, 0.f, 0.f, 0.f};
#pragma unroll
        for (int k4 = 0; k4 < 4; ++k4) O[vt] = __builtin_amdgcn_mfma_f32_16x16x32_bf16(sf[vt][k4], qf[k4], O[vt], 0, 0, 0);
#pragma unroll
        for (int p = 0; p < 2; ++p) if (2 * p <= J) { s16x4 lo, hi2;
            asm volatile("ds_read_b64_tr_b16 %0, %1" : "=&v"(lo) : "v"(vtr + (32 * p) * RSV + (16 * vt) * 2) : "memory");
            asm volatile("ds_read_b64_tr_b16 %0, %1" : "=&v"(hi2) : "v"(vtr + (32 * p + 16) * RSV + (16 * vt) * 2) : "memory");
            asm volatile("s_waitcnt lgkmcnt(0)" ::: "memory"); __builtin_amdgcn_sched_barrier(0);
            const bf16x8 vf = {lo[0], lo[1], lo[2], lo[3], hi2[0], hi2[1], hi2[2], hi2[3]};
            O[vt] = __builtin_amdgcn_mfma_f32_16x16x32_bf16(vf, Bf[p], O[vt], 0, 0, 0); }
        ss += (O[vt][0] * O[vt][0] + O[vt][1] * O[vt][1]) + (O[vt][2] * O[vt][2] + O[vt][3] * O[vt][3]); }
    ss += __shfl_xor(ss, 16); ss += __shfl_xor(ss, 32);
    HLAS float* SS = (HLAS float*)(lds + P3_SS);
    if (g == 0) SS[vh * 64 + 16 * J + tl] = ss;
    HG_SYNC();
    f32x4 fac[4];
#pragma unroll
    for (int vt = 0; vt < 4; ++vt) fac[vt] = (f32x4){gwv[vt].x * bflo(gg[vt].x), gwv[vt].y * bfhi(gg[vt].x), gwv[vt].z * bflo(gg[vt].y), gwv[vt].w * bfhi(gg[vt].y)};
    asm volatile("" :: "v"(fac[0].x), "v"(fac[0].y), "v"(fac[0].z), "v"(fac[0].w), "v"(fac[1].x), "v"(fac[1].y), "v"(fac[1].z), "v"(fac[1].w), "v"(fac[2].x), "v"(fac[2].y), "v"(fac[2].z), "v"(fac[2].w), "v"(fac[3].x), "v"(fac[3].y), "v"(fac[3].z), "v"(fac[3].w) : "memory");
    __builtin_amdgcn_sched_barrier(0);
    if (next_unit >= 0) pass3_sdma(ST, next_unit, lds, wid, lane);
    const float tot = SS[16 * J + tl] + SS[64 + 16 * J + tl];
    const float rstd = 1.0f / sqrtf(tot * (1.0f / 128.0f) + 1e-6f);
#pragma unroll
    for (int vt = 0; vt < 4; ++vt) { const int v4 = 64 * vh + 16 * vt + 4 * g;
        u32x2 o; o.x = cvtpk(O[vt][0] * rstd * fac[vt].x, O[vt][1] * rstd * fac[vt].y); o.y = cvtpk(O[vt][2] * rstd * fac[vt].z, O[vt][3] * rstd * fac[vt].w);
        *(HGAS u32x2*)(MIX + orow * 4096 + 2048 + h * 128 + v4) = o; }
    HG_SYNC();
}
__device__ __forceinline__ void pass3_all(const bf16_t* KF, const bf16_t* QH, const bf16_t* VH, const bf16_t* GH, const bf16_t* ST, const float* gout, bf16_t* MIX, int u0, int ustride, HLAS char* lds, int wid_in) {
    const int wid = __builtin_amdgcn_readfirstlane(wid_in), lane = hw_lane(), tid = wid * 64 + lane;
    P3In A, B;
    int u = u0;
    if (u < NUNIT) { pass3_sdma(ST, u, lds, wid, lane); pass3_load(A, KF, QH, VH, u, tid); }
    while (u < NUNIT) {
        const int u2 = u + ustride, u3 = u2 + ustride;
        if (u2 < NUNIT) pass3_load(B, KF, QH, VH, u2, tid);
        pass3_compute(A, GH, ST, gout, MIX, u, u2 < NUNIT ? u2 : -1, u2 < NUNIT, lds, wid, lane);
        if (u2 >= NUNIT) break;
        if (u3 < NUNIT) pass3_load(A, KF, QH, VH, u3, tid);
        pass3_compute(B, GH, ST, gout, MIX, u2, u3 < NUNIT ? u3 : -1, u3 < NUNIT, lds, wid, lane);
        u = u3;
    }
}
}

constexpr int NWAVES = 8;
#ifndef MK_ONE_LAUNCH
#define MK_ONE_LAUNCH 1
#endif
constexpr int N_PHASES = 14;
#ifndef PROBE_DUP
#define PROBE_DUP -1
#endif
constexpr int BATCH = 4, SEQ = 4096, DM = 4096, M = BATCH * SEQ, DFF = 16384, PLE = 256;
constexpr int QLORA = 768, KVLORA = 512, HGD = 2048, INW = 9536, INWP = 9728;
constexpr float EPS = 1e-6f;
constexpr float QSCALE = 0.07216878364870322f * 1.4426950408889634f;
constexpr size_t MiB = 1u << 20;
constexpr size_t WS_CTL = 0, CTL_ZERO_BYTES = 64 * 1024;
constexpr size_t WS_RSX = 1 * MiB, WS_RSQ = WS_RSX + 65536, WS_RSKV = WS_RSQ + 65536, WS_RS1 = WS_RSKV + 65536, WS_RS2 = WS_RS1 + 65536, WS_RSE = WS_RS2 + 65536, WS_LB = WS_RSE + 65536;
constexpr size_t WS_RC = 2 * MiB, WS_RSN = 4 * MiB, WS_KRAW = 6 * MiB, WS_KR = 10 * MiB, WS_PB = 12 * MiB;
constexpr size_t WS_WIN = 20 * MiB, WS_WUQ = 96 * MiB, WS_WUKV = 101 * MiB, WS_WO = 105 * MiB, WS_WPG = 137 * MiB, WS_WPLE = 169 * MiB;
constexpr size_t WS_A = 172 * MiB;
constexpr size_t WS_MIX = 940 * MiB;
constexpr size_t WS_B = 300 * MiB;
constexpr size_t WS_C = 428 * MiB;
constexpr size_t WS_D = 556 * MiB;
constexpr size_t WS_E = 684 * MiB;
constexpr size_t WS_F = 812 * MiB;
constexpr size_t WS_CQ = WS_F, WS_CKV = WS_F + 24 * MiB, WS_QH = WS_F + 40 * MiB, WS_HID = WS_F, WS_DD = WS_F + 104 * MiB  , WS_END = WS_F + 256 * MiB;
static_assert(WS_WIN + (size_t)INWP * DM * 2 <= WS_WUQ && WS_WPLE + (size_t)DM * PLE * 2 <= WS_A && WS_END == 1068 * MiB, "d_ws map");
constexpr int RING_OFF = 0, RING_BYTES = 131072, LDSCTL_OFF = RING_BYTES, MISC_OFF = LDSCTL_OFF + 320, LDS_BYTES = 148480;

#define GAS __attribute__((address_space(1)))
#define LAS __attribute__((address_space(3)))
typedef unsigned short bf16;
typedef unsigned v4u __attribute__((ext_vector_type(4)));
typedef unsigned v2u __attribute__((ext_vector_type(2)));
typedef float f32x4 __attribute__((ext_vector_type(4)));
typedef float f32x2 __attribute__((ext_vector_type(2)));
typedef GAS unsigned gu32;
#define RLX_AGENT __ATOMIC_RELAXED, __HIP_MEMORY_SCOPE_AGENT
#define LDS_WAIT() asm volatile("s_waitcnt lgkmcnt(0)" ::: "memory")
__device__ __forceinline__ unsigned pk2(float lo, float hi) { unsigned r; asm volatile("s_nop 0\n\tv_cvt_pk_bf16_f32 %0, %1, %2" : "=v"(r) : "v"(lo), "v"(hi)); return r; }
__device__ __forceinline__ float bf_lo(unsigned w) { return __uint_as_float(w << 16); }
__device__ __forceinline__ float bf_hi(unsigned w) { return __uint_as_float(w & 0xffff0000u); }

#define XB_TMO      128
#define XB_XCNT(j)  (256  + 64 * (j))
#define XB_XSUB(j)  (1280 + 64 * (j))
#define XB_XGEN(j)  (2304 + 64 * (j))
#define XB_TOP      3328
#define XB_TOPGEN   3392
#define XCD_BAR_WORDS 3456
#define XB_SPIN_CAP (1u << 18)

__device__ __forceinline__ unsigned xb_ld(unsigned* p)              { return __hip_atomic_load(p, __ATOMIC_RELAXED, __HIP_MEMORY_SCOPE_AGENT); }
__device__ __forceinline__ unsigned xb_add(unsigned* p, unsigned v) { return __hip_atomic_fetch_add(p, v, __ATOMIC_RELAXED, __HIP_MEMORY_SCOPE_AGENT); }
__device__ __forceinline__ unsigned xb_xcc_id() { return (unsigned)__builtin_amdgcn_s_getreg((3 << 11) | 20) & 0xFu; }
#define XB_SPIN(cond, bar) do { unsigned _sp = 0; while (cond) { __builtin_amdgcn_s_sleep(1); \
    if ((++_sp & 255u) == 0u) { if (xb_ld(&(bar)[XB_TMO])) break; if (_sp > XB_SPIN_CAP) { atomicAdd(&(bar)[XB_TMO], 1u); break; } } } } while (0)

struct XcdBarrier {
    int wave;
    unsigned* bar; unsigned x;
    volatile LAS unsigned* st;
};

__device__ __forceinline__ XcdBarrier xcd_barrier_post(unsigned* bar, volatile LAS unsigned* st, int wave) {
    XcdBarrier b; b.wave = wave; b.bar = bar; b.x = xb_xcc_id(); b.st = st;
    if (wave == 0 && hw_lane() == 0) (void)xb_add(&bar[XB_XCNT(b.x)], 1u);
    return b;
}
__device__ __forceinline__ void xcd_barrier_complete(unsigned* bar, unsigned x, unsigned& nloc, unsigned& nx) {
    const unsigned G = gridDim.x * gridDim.y * gridDim.z;
    unsigned sum, cnt, mine, sp = 0u;
    for (;;) {
        sum = 0u; cnt = 0u; mine = 0u;
#pragma unroll
        for (unsigned j = 0; j < 16; ++j) { const unsigned c = xb_ld(&bar[XB_XCNT(j)]); sum += c; cnt += (c > 0u) ? 1u : 0u; mine = (j == x) ? c : mine; }
        if (sum == G) break;
        __builtin_amdgcn_s_sleep(1);
        if ((++sp & 255u) == 0u) { if (xb_ld(&bar[XB_TMO])) break; if (sp > XB_SPIN_CAP) { atomicAdd(&bar[XB_TMO], 1u); break; } }
    }
    nloc = mine > 0u ? mine : 1u; nx = cnt > 0u ? cnt : 1u;
}

__device__ __forceinline__ void xcd_barrier(const XcdBarrier& b) {
    asm volatile("s_waitcnt vmcnt(0)" ::: "memory");
    __syncthreads();
    if (b.wave == 0 && hw_lane() == 0) {
        unsigned* bar = b.bar;
        __builtin_amdgcn_s_waitcnt(0);
        unsigned nloc = b.st[0], nx = b.st[1];
        if (nloc == 0u) { xcd_barrier_complete(bar, b.x, nloc, nx); b.st[0] = nloc; b.st[1] = nx; }
        const unsigned old = xb_add(&bar[XB_XSUB(b.x)], 1u);
        const unsigned gen = old / nloc;
        if (old + 1u == (gen + 1u) * nloc) {
            __builtin_amdgcn_fence(__ATOMIC_RELEASE, "agent");
            asm volatile("s_waitcnt vmcnt(0)" ::: "memory");
            const unsigned og = xb_add(&bar[XB_TOP], 1u);
            const unsigned tg = og / nx;
            if (og + 1u == (tg + 1u) * nx) xb_add(&bar[XB_TOPGEN], 1u);
            else XB_SPIN(xb_ld(&bar[XB_TOPGEN]) == tg, bar);
            __builtin_amdgcn_fence(__ATOMIC_ACQUIRE, "agent");
            xb_add(&bar[XB_XGEN(b.x)], 1u);
            asm volatile("s_waitcnt vmcnt(0)" ::: "memory");
        } else {
            XB_SPIN(xb_ld(&bar[XB_XGEN(b.x)]) == gen, bar);
            __builtin_amdgcn_fence(__ATOMIC_ACQUIRE, "agent");
            asm volatile("s_waitcnt vmcnt(0)" ::: "memory");
        }
    }
    __syncthreads();
}

__device__ __forceinline__ float wave_sum(float v) {
#pragma unroll
    for (int o = 1; o < 64; o <<= 1) v += __shfl_xor(v, o);
    return v;
}
struct TrItem { f32x4 v[16]; };
__device__ __forceinline__ void tr_load(TrItem& T, const float* W, int N, int k0, int n0, const float* g, int lane, float wscale) {
    const float* p = W + (size_t)(k0 + (lane >> 4)) * N + n0 + 4 * (lane & 15);
#pragma unroll
    for (int i = 0; i < 16; ++i) { T.v[i] = __builtin_nontemporal_load((const GAS f32x4*)(p + (size_t)(4 * i) * N)); }
    if (g) {
#pragma unroll
        for (int i = 0; i < 16; ++i) T.v[i] = T.v[i] * (g[k0 + 4 * i + (lane >> 4)] * wscale); }
}
template <bool FP8>
__device__ __forceinline__ void tr_store(const TrItem& T, int K, bf16* WT, int k0, int drow0, LAS unsigned* scr, int lane) {
    const int r = lane >> 4, c = lane & 15;
#pragma unroll
    for (int i = 0; i < 16; ++i) { scr[(4 * i + r) * 33 + 2 * c] = pk2(T.v[i].x, T.v[i].y); scr[(4 * i + r) * 33 + 2 * c + 1] = pk2(T.v[i].z, T.v[i].w); }
    LDS_WAIT(); asm volatile("" ::: "memory");
    const int kc = lane & 7;
#pragma unroll
    for (int j = 0; j < 4; ++j) { const int np = 8 * j + (lane >> 3); unsigned d[8];
#pragma unroll
        for (int e = 0; e < 8; ++e) d[e] = scr[(8 * kc + e) * 33 + np];
        if constexpr (FP8) {
            int l0 = 0, l1 = 0, h0 = 0, h1 = 0;
            l0 = __builtin_amdgcn_cvt_pk_fp8_f32(bf_lo(d[0]), bf_lo(d[1]), l0, false); l0 = __builtin_amdgcn_cvt_pk_fp8_f32(bf_lo(d[2]), bf_lo(d[3]), l0, true);
            l1 = __builtin_amdgcn_cvt_pk_fp8_f32(bf_lo(d[4]), bf_lo(d[5]), l1, false); l1 = __builtin_amdgcn_cvt_pk_fp8_f32(bf_lo(d[6]), bf_lo(d[7]), l1, true);
            h0 = __builtin_amdgcn_cvt_pk_fp8_f32(bf_hi(d[0]), bf_hi(d[1]), h0, false); h0 = __builtin_amdgcn_cvt_pk_fp8_f32(bf_hi(d[2]), bf_hi(d[3]), h0, true);
            h1 = __builtin_amdgcn_cvt_pk_fp8_f32(bf_hi(d[4]), bf_hi(d[5]), h1, false); h1 = __builtin_amdgcn_cvt_pk_fp8_f32(bf_hi(d[6]), bf_hi(d[7]), h1, true);
            unsigned char* o = (unsigned char*)WT + (size_t)(drow0 + 2 * np) * K + k0 + 8 * kc;
            *(GAS v2u*)o = (v2u){(unsigned)l0, (unsigned)l1}; *(GAS v2u*)(o + K) = (v2u){(unsigned)h0, (unsigned)h1};
        } else {
        v4u lo, hi;
        lo.x = (d[0] & 0xffffu) | (d[1] << 16); lo.y = (d[2] & 0xffffu) | (d[3] << 16); lo.z = (d[4] & 0xffffu) | (d[5] << 16); lo.w = (d[6] & 0xffffu) | (d[7] << 16);
        hi.x = (d[0] >> 16) | (d[1] & 0xffff0000u); hi.y = (d[2] >> 16) | (d[3] & 0xffff0000u); hi.z = (d[4] >> 16) | (d[5] & 0xffff0000u); hi.w = (d[6] >> 16) | (d[7] & 0xffff0000u);
        bf16* o = WT + (size_t)(drow0 + 2 * np) * K + k0 + 8 * kc;
        *(GAS v4u*)o = lo; *(GAS v4u*)(o + K) = hi; } }
    LDS_WAIT(); asm volatile("" ::: "memory");
}
template <bool FP8 = false>
__device__ __forceinline__ void transpose_matrix(const float* W, int K, int N, bf16* WT, const float* g, LAS float* scrf, int gw, int NGW, int lane, bool is_win, float wscale = 1.0f) {
    LAS unsigned* scr = (LAS unsigned*)scrf;
    const int nblk = N / 64, nitems = (K / 64) * nblk;
    TrItem A, B;
#define TR_LD(X, it_) do { const int kb_ = (it_) / nblk, nb_ = (it_) - kb_ * nblk; tr_load(X, W, N, 64 * kb_, 64 * nb_, g, lane, wscale); } while (0)
#define TR_ST(X, it_) do { const int kb_ = (it_) / nblk, nb_ = (it_) - kb_ * nblk, n0_ = 64 * nb_; tr_store<FP8>(X, K, WT, 64 * kb_, (is_win && n0_ >= 1344) ? n0_ + 192 : n0_, scr, lane); } while (0)
    int it = gw;
    if (it < nitems) TR_LD(A, it);
    while (it < nitems) {
        const int it2 = it + NGW, it3 = it2 + NGW;
        if (it2 < nitems) TR_LD(B, it2);
        TR_ST(A, it);
        if (it2 >= nitems) break;
        if (it3 < nitems) TR_LD(A, it3);
        TR_ST(B, it2);
        it = it3;
    }
#undef TR_LD
#undef TR_ST
}
__device__ __forceinline__ float row_ss_bf16_4096(const bf16* row, int lane) {
    float s = 0.f;
#pragma unroll
    for (int j = 0; j < 8; ++j) { const v4u w = *(const GAS v4u*)(row + 8 * lane + 512 * j);
#pragma unroll
        for (int e = 0; e < 4; ++e) { const float a = bf_lo(w[e]), b = bf_hi(w[e]); s += a * a + b * b; } }
    return wave_sum(s);
}
__device__ __forceinline__ void rstd_rows_4096(const bf16* src, float* dst, int gw, int NGW, int lane) {
    for (int m = gw; m < M; m += NGW) { const float ss = row_ss_bf16_4096(src + (size_t)m * DM, lane); if (lane == 0) dst[m] = 1.0f / sqrtf(ss * (1.0f / DM) + EPS); }
}
__constant__ double ROPE_INVF[32] = {1.0, 0.7498942093324559, 0.5623413251903491, 0.4216965034285822, 0.31622776601683794, 0.23713737056616552, 0.1778279410038923, 0.1333521432163324, 0.1, 0.07498942093324558,
    0.05623413251903491, 0.042169650342858224, 0.03162277660168379, 0.023713737056616554, 0.01778279410038923, 0.01333521432163324, 0.01, 0.007498942093324558, 0.005623413251903491, 0.004216965034285823,
    0.0031622776601683794, 0.0023713737056616554, 0.0017782794100389228, 0.001333521432163324, 0.001, 0.0007498942093324559, 0.0005623413251903491, 0.00042169650342858224, 0.00031622776601683794,
    0.00023713737056616554, 0.00017782794100389227, 0.0001333521432163324};
__device__ __forceinline__ void rope_cs(int pos, int i, float& c, float& s) {
    const double th = (double)pos * ROPE_INVF[i];
    const double k = __builtin_rint(th * 0.6366197723675814);
    double r = __builtin_fma(-k, 1.5707963267948966, th); r = __builtin_fma(-k, 6.123233995736766e-17, r);
    const double r2 = r * r;
    double sp = -1.0 / 39916800.0; sp = __builtin_fma(sp, r2, 1.0 / 362880.0); sp = __builtin_fma(sp, r2, -1.0 / 5040.0); sp = __builtin_fma(sp, r2, 1.0 / 120.0); sp = __builtin_fma(sp, r2, -1.0 / 6.0); sp = __builtin_fma(sp, r2, 1.0); sp *= r;
    double cp = 1.0 / 479001600.0; cp = __builtin_fma(cp, r2, -1.0 / 3628800.0); cp = __builtin_fma(cp, r2, 1.0 / 40320.0); cp = __builtin_fma(cp, r2, -1.0 / 720.0); cp = __builtin_fma(cp, r2, 1.0 / 24.0); cp = __builtin_fma(cp, r2, -0.5); cp = __builtin_fma(cp, r2, 1.0);
    const int q = (int)((long long)k & 3);
    const double sv = (q == 0) ? sp : (q == 1) ? cp : (q == 2) ? -sp : -cp;
    const double cv = (q == 0) ? cp : (q == 1) ? -sp : (q == 2) ? -cp : sp;
    c = (float)cv; s = (float)sv;
}


struct Args { const float* in[20]; float* out; unsigned char* ws; int ph_lo, ph_hi; };
__global__ void __launch_bounds__(NWAVES * 64, 2) hymba_fwd(Args args) {
    extern __shared__ __attribute__((aligned(16))) unsigned char lds_raw[];
    LAS unsigned char* lds = (LAS unsigned char*)lds_raw;
    const int wave = __builtin_amdgcn_readfirstlane((int)threadIdx.x >> 6);
#define lane hw_lane()
#define tid (wave * 64 + hw_lane())
    const int G = gridDim.x; const int bx = blockIdx.x; const int vcu = (G % 8 == 0) ? (bx % 8) * (G / 8) + bx / 8 : bx;
    const int gw = vcu * NWAVES + wave, NGW = G * NWAVES;
    gu32* ctl = (gu32*)(args.ws + WS_CTL);
#define x_in (args.in[0])
#define p_in (args.in[1])
#define positions ((const int*)args.in[2])
#define norm_mix (args.in[3])
#define w_in (args.in[4])
#define q_a_norm (args.in[5])
#define kv_a_norm (args.in[6])
#define w_uq (args.in[7])
#define w_ukv (args.in[8])
#define hg_lb (args.in[9])
#define hg_out_norm (args.in[10])
#define w_o (args.in[11])
#define norm_mlp (args.in[12])
#define w_up (args.in[13])
#define w_down (args.in[14])
#define norm_ple (args.in[15])
#define w_pg (args.in[16])
#define w_ple (args.in[17])
#define ple_post (args.in[18])
#define final_norm (args.in[19])
#define out (args.out)
#define RSX ((float*)(ws + WS_RSX))
#define RSQ ((float*)(ws + WS_RSQ))
#define RSKV ((float*)(ws + WS_RSKV))
#define RS1 ((float*)(ws + WS_RS1))
#define RS2 ((float*)(ws + WS_RS2))
#define RSE ((float*)(ws + WS_RSE))
#define LB ((float*)(ws + WS_LB))
#define RC ((float*)(ws + WS_RC))
#define RSN ((float*)(ws + WS_RSN))
#define KRAW ((float*)(ws + WS_KRAW))
#define KR ((bf16*)(ws + WS_KR))
#define PB ((bf16*)(ws + WS_PB))
#define WIN ((bf16*)(ws + WS_WIN))
#define WUQ ((bf16*)(ws + WS_WUQ))
#define WUKV ((bf16*)(ws + WS_WUKV))
#define WO ((bf16*)(ws + WS_WO))
#define WPG ((bf16*)(ws + WS_WPG))
#define WPLE ((bf16*)(ws + WS_WPLE))
#define H2F ((unsigned char*)(ws + WS_WIN))
#define XB ((bf16*)(ws + WS_A))
#define MIX ((bf16*)(ws + WS_MIX))
#define H2B ((bf16*)(ws + WS_A))
#define KV ((bf16*)(ws + WS_B))
#define H1B ((bf16*)(ws + WS_B))
#define Q ((bf16*)(ws + WS_C))
#define WUP ((bf16*)(ws + WS_C))
#define WDN ((bf16*)(ws + WS_D))
#define VH ((bf16*)(ws + WS_E))
#define GH ((bf16*)(ws + WS_E + 64 * MiB))
#define EB ((bf16*)(ws + WS_E))
#define CQ ((bf16*)(ws + WS_CQ))
#define CKV ((bf16*)(ws + WS_CKV))
#define QH ((bf16*)(ws + WS_QH))
#define HID ((bf16*)(ws + WS_HID))
#define ws (args.ws)
#define FF ((bf16*)out)
#define UT ((bf16*)(ws + WS_D))
#define DDK ((float*)(ws + WS_DD))

    for (int u = tid; u < (LDS_BYTES - LDSCTL_OFF) / 4; u += NWAVES * 64) ((LAS unsigned*)(lds + LDSCTL_OFF))[u] = 0u;
    __syncthreads();
    volatile LAS unsigned* MISC = (volatile LAS unsigned*)(lds + MISC_OFF);
    XcdBarrier bar; bar.wave = wave; bar.bar = (unsigned*)(ctl + 1024); bar.x = 0; bar.st = nullptr;
    if (MK_ONE_LAUNCH) bar = xcd_barrier_post((unsigned*)(ctl + 1024), MISC + 8, wave);
    const int lo = args.ph_lo, hi = args.ph_hi;
#define IN(k) (lo <= (k) && (k) < hi)
#define SEAM(k) do { if (IN(k) && IN((k) + 1)) xcd_barrier(bar); } while (0)
    LAS float* scr = (LAS float*)(lds + RING_OFF + wave * 16384);

    if (IN(0)) {
        transpose_matrix(w_in, DM, INW, WIN, norm_mix, scr, gw, NGW, lane, true);
        transpose_matrix(w_uq, QLORA, 3072, WUQ, q_a_norm, scr, gw, NGW, lane, false);
        transpose_matrix(w_ukv, KVLORA, 4096, WUKV, kv_a_norm, scr, gw, NGW, lane, false);
        { const int gt = gw * 64 + lane, NGT = NGW * 64;
          for (int i = gt; i < 192 * DM / 8; i += NGT) *(GAS v4u*)(WIN + (size_t)1344 * DM + (size_t)i * 8) = (v4u){0u, 0u, 0u, 0u};
          for (int i = gt; i < M * 32; i += NGT) { float c, s; rope_cs(positions[i >> 5], i & 31, c, s); RC[i] = c; RSN[i] = s; }
          for (int i = gt; i < HGD; i += NGT) LB[i] = 1.0f / (1.0f + expf(hg_lb[HGD + i] - hg_lb[i]));
          for (int i = gt; i < M; i += NGT) { RS1[i] = 0.f; RS2[i] = 0.f; RSE[i] = 0.f; RSQ[i] = 0.f; RSKV[i] = 0.f; }
          for (int i = gt; i < M * PLE / 8; i += NGT) { const f32x4 a = *(const GAS f32x4*)(p_in + (size_t)i * 8), b = *(const GAS f32x4*)(p_in + (size_t)i * 8 + 4);
              *(GAS v4u*)(PB + (size_t)i * 8) = (v4u){pk2(a.x, a.y), pk2(a.z, a.w), pk2(b.x, b.y), pk2(b.z, b.w)}; } }
        for (int m = gw; m < M; m += NGW) { const GAS f32x4* xr = (const GAS f32x4*)(x_in + (size_t)m * DM) + lane; f32x4 v[16]; float s = 0.f;
#pragma unroll
            for (int j = 0; j < 16; ++j) { v[j] = __builtin_nontemporal_load(xr + 64 * j); s += (v[j].x * v[j].x + v[j].y * v[j].y) + (v[j].z * v[j].z + v[j].w * v[j].w); }
            s = wave_sum(s); if (lane == 0) RSX[m] = 1.0f / sqrtf(s * (1.0f / DM) + EPS);
            GAS v2u* o8 = (GAS v2u*)(XB + (size_t)m * DM) + lane;
#pragma unroll
            for (int j = 0; j < 16; ++j) o8[64 * j] = (v2u){pk2(v[j].x, v[j].y), pk2(v[j].z, v[j].w)}; }
    }
    SEAM(0);
    if (IN(1)) {
        pg8::Gemm g{XB, WIN, M, INWP, DM}; pg8::StaticOrder S; S.init(M, INWP, G, bx);
        pg8::EpiProj E{CQ, CKV, KRAW, QH, FF, VH, GH, RSX, LB, RSQ, RSKV};
        pg8::gemm_phase<pg8::EpiProj, pg8::StaticOrder, true, true>(lds + RING_OFF, g, S, E, wave);
        { const int nwg = (M / 256) * (INWP / 256), R = (nwg + G - 1) / G, nshort = R * G - nwg; const int first = (nshort == 0) ? 0 : G - nshort, cnt = (nshort == 0) ? G : nshort;
          if (bx >= first) { const int gw2 = (bx - first) * NWAVES + wave, NGW2 = cnt * NWAVES;
              transpose_matrix(w_o, DM, DM, WO, nullptr, scr, gw2, NGW2, lane, false);
              transpose_matrix<true>(w_pg, DM, DM, WPG, norm_ple, scr, gw2, NGW2, lane, false, 64.0f);
              transpose_matrix(w_ple, PLE, DM, WPLE, nullptr, scr, gw2, NGW2, lane, false); } }
    }
    SEAM(1);
    if (IN(2)) {
        for (int i = gw * 64 + lane; i < M * 32; i += NGW * 64) { const int m = i >> 5, l = i & 31;
            const float x1 = KRAW[(size_t)m * 64 + l], x2 = KRAW[(size_t)m * 64 + 32 + l], c = RC[i], sn = RSN[i];
            KR[(size_t)m * 64 + l] = (bf16)(pk2(x1 * c - x2 * sn, 0.f) & 0xffffu); KR[(size_t)m * 64 + 32 + l] = (bf16)(pk2(x2 * c + x1 * sn, 0.f) & 0xffffu); }
        hg::pass1_all(FF, VH, UT, DDK, vcu, G, (LAS char*)(lds + RING_OFF), wave);
    }
    SEAM(2);
    if (IN(3)) {
        const bool scan_first = (G % 8 == 0) && (((vcu / (G / 8)) & 1) == 0);
        if (scan_first) hg::pass2_scan(UT, DDK, gw * 64 + lane, NGW * 64);
        { pg8::Gemm g{CQ, WUQ, M, 3072, QLORA}; pg8::StaticOrder S; S.init(M, 3072, G, bx); pg8::EpiRowScale E{Q, 3072, RSQ, QSCALE, nullptr, 1.0f / QLORA, EPS};
          pg8::gemm_phase<pg8::EpiRowScale, pg8::StaticOrder, true, true>(lds + RING_OFF, g, S, E, wave); }
        { pg8::Gemm g{CKV, WUKV, M, 4096, KVLORA}; pg8::StaticOrder S; S.init(M, 4096, G, bx); pg8::EpiRowScale E{KV, 4096, RSKV, 1.0f, nullptr, 1.0f / KVLORA, EPS};
          pg8::gemm_phase<pg8::EpiRowScale, pg8::StaticOrder, true, true>(lds + RING_OFF, g, S, E, wave); }
        if (!scan_first) hg::pass2_scan(UT, DDK, gw * 64 + lane, NGW * 64);
    }
    SEAM(3);
    if (IN(4)) {
        const att::Tensors T{Q, KV, KR, RC, RSN, MIX};
        for (int pi = vcu; pi < 512; pi += G) { const int bh = pi >> 3, s = pi & 7; att::unit(T, bh, 15 - s, (LAS char*)(lds + RING_OFF), wave); att::unit(T, bh, s, (LAS char*)(lds + RING_OFF), wave); }
        hg::pass3_all(FF, QH, VH, GH, UT, hg_out_norm, MIX, vcu, G, (LAS char*)(lds + RING_OFF), wave);
    }
    SEAM(4);
    if (IN(5)) {
        const bool conv_first = (G % 8 == 0) ? (((vcu / (G / 8)) & 1) != 0) : ((vcu & 1) != 0);
        if (conv_first) { transpose_matrix(w_up, DM, DFF, WUP, norm_mlp, scr, gw, NGW, lane, false); transpose_matrix(w_down, DFF, DM, WDN, nullptr, scr, gw, NGW, lane, false); __syncthreads(); }
        { pg8::Gemm g{MIX, WO, M, DM, DM}; pg8::StaticOrder S; S.init(M, DM, G, bx); pg8::EpiResidB E{XB, H1B, nullptr, DM, RS1, false, true};
          pg8::gemm_phase<pg8::EpiResidB, pg8::StaticOrder, true, true>(lds + RING_OFF, g, S, E, wave); }
        { pg8::Gemm g{PB, WPLE, M, DM, PLE}; pg8::StaticOrder S; S.init(M, DM, G, bx); pg8::EpiRowScale E{EB, DM, nullptr, 1.0f, RSE, 0.f, 0.f};
          pg8::gemm_phase<pg8::EpiRowScale, pg8::StaticOrder, true, true>(lds + RING_OFF, g, S, E, wave); }
        if (!conv_first) { transpose_matrix(w_up, DM, DFF, WUP, norm_mlp, scr, gw, NGW, lane, false); transpose_matrix(w_down, DFF, DM, WDN, nullptr, scr, gw, NGW, lane, false); }
    }
    SEAM(5);
    if (IN(7)) { pg8::Gemm g{H1B, WUP, M / 2, DFF, DM}; pg8::StaticOrder S; S.init(M / 2, DFF, G, bx); pg8::EpiRelu2 E{HID, DFF, RS1, 1.0f / DM, EPS};
        pg8::gemm_phase<pg8::EpiRelu2, pg8::StaticOrder, true, true, false, true>(lds + RING_OFF, g, S, E, wave); }
    SEAM(7);
    if (IN(8)) { pg8::Gemm g{HID, WDN, M / 2, DM, DFF}; pg8::StaticOrder S; S.init(M / 2, DM, G, bx); pg8::EpiResidB E{H1B, H2B, H2F, DM, RS2, true, false};
        pg8::gemm_phase<pg8::EpiResidB, pg8::StaticOrder, true, true, false, true>(lds + RING_OFF, g, S, E, wave); }
    SEAM(8);
    if (IN(9)) { pg8::Gemm g{H1B + (size_t)(M / 2) * DM, WUP, M / 2, DFF, DM}; pg8::StaticOrder S; S.init(M / 2, DFF, G, bx); pg8::EpiRelu2 E{HID, DFF, RS1 + M / 2, 1.0f / DM, EPS};
        pg8::gemm_phase<pg8::EpiRelu2, pg8::StaticOrder, true, true, false, true>(lds + RING_OFF, g, S, E, wave); }
    SEAM(9);
    if (IN(10)) { pg8::Gemm g{HID, WDN, M / 2, DM, DFF}; pg8::StaticOrder S; S.init(M / 2, DM, G, bx); pg8::EpiResidB E{H1B + (size_t)(M / 2) * DM, H2B + (size_t)(M / 2) * DM, H2F + (size_t)(M / 2) * DM, DM, RS2 + M / 2, true, false};
        pg8::gemm_phase<pg8::EpiResidB, pg8::StaticOrder, true, true, false, true>(lds + RING_OFF, g, S, E, wave); }
    SEAM(10);
    if (IN(12)) { pg8::Gemm g{(const bf16*)H2F, WPG, M, DM, DM / 2}; pg8::StaticOrder S; S.init(M, DM, G, bx); pg8::EpiGateOnly E{(unsigned char*)WUP, RS2, DM, 1.0f / 64.0f, 1.0f / DM, EPS};
        pg8::gemm_phase<pg8::EpiGateOnly, pg8::StaticOrder, true, true, true, true>(lds + RING_OFF, g, S, E, wave); }
    SEAM(12);
    if (IN(13)) {
        for (int m = gw; m < M; m += NGW) {
            const bf16* hr = H2B + (size_t)m * DM + 8 * lane; const unsigned char* gr = (const unsigned char*)WUP + (size_t)m * DM + 8 * lane; const bf16* er = EB + (size_t)m * DM + 8 * lane;
            v4u wh[8], we[8]; v2u wg[8];
#pragma unroll
            for (int j = 0; j < 8; ++j) { wh[j] = *(const GAS v4u*)(hr + 512 * j); wg[j] = *(const GAS v2u*)(gr + 512 * j); we[j] = *(const GAS v4u*)(er + 512 * j); }
            const float rse = 1.0f / sqrtf(RSE[m] * (1.0f / DM) + EPS);
            float h3[64]; float s = 0.f;
#pragma unroll
            for (int j = 0; j < 8; ++j) { const f32x4 p0 = *(const GAS f32x4*)(ple_post + 8 * lane + 512 * j), p1 = *(const GAS f32x4*)(ple_post + 8 * lane + 512 * j + 4);
#pragma unroll
                for (int e = 0; e < 4; ++e) { const float pl = e < 2 ? p0[2 * e] : p1[2 * e - 4], ph = e < 2 ? p0[2 * e + 1] : p1[2 * e - 3];
                    const unsigned gq = wg[j][e >> 1] >> (16 * (e & 1)); const float gl = (float)(gq & 0xffu) * (1.0f / 255.0f), gh = (float)((gq >> 8) & 0xffu) * (1.0f / 255.0f);
                    const float a = bf_lo(wh[j][e]) + gl * (bf_lo(we[j][e]) * rse * pl), b = bf_hi(wh[j][e]) + gh * (bf_hi(we[j][e]) * rse * ph);
                    h3[8 * j + 2 * e] = a; h3[8 * j + 2 * e + 1] = b; s += a * a + b * b; } }
            s = wave_sum(s); const float rstd = 1.0f / sqrtf(s * (1.0f / DM) + EPS);
            float* orow = out + (size_t)m * DM + 8 * lane;
#pragma unroll
            for (int j = 0; j < 8; ++j) { const f32x4 g0 = *(const GAS f32x4*)(final_norm + 8 * lane + 512 * j), g1 = *(const GAS f32x4*)(final_norm + 8 * lane + 512 * j + 4);
                f32x4 o0, o1; o0.x = h3[8 * j] * rstd * g0.x; o0.y = h3[8 * j + 1] * rstd * g0.y; o0.z = h3[8 * j + 2] * rstd * g0.z; o0.w = h3[8 * j + 3] * rstd * g0.w;
                o1.x = h3[8 * j + 4] * rstd * g1.x; o1.y = h3[8 * j + 5] * rstd * g1.y; o1.z = h3[8 * j + 6] * rstd * g1.z; o1.w = h3[8 * j + 7] * rstd * g1.w;
                __builtin_nontemporal_store(o0, (GAS f32x4*)(orow + 512 * j)); __builtin_nontemporal_store(o1, (GAS f32x4*)(orow + 512 * j + 4)); }
        }
    }
#undef IN
#undef SEAM
#undef lane
#undef tid
#undef x_in
#undef p_in
#undef positions
#undef norm_mix
#undef w_in
#undef q_a_norm
#undef kv_a_norm
#undef w_uq
#undef w_ukv
#undef hg_lb
#undef hg_out_norm
#undef w_o
#undef norm_mlp
#undef w_up
#undef w_down
#undef norm_ple
#undef w_pg
#undef w_ple
#undef ple_post
#undef final_norm
#undef out
#undef RSX
#undef RSQ
#undef RSKV
#undef RS1
#undef RS2
#undef RSE
#undef LB
#undef RC
#undef RSN
#undef KRAW
#undef KR
#undef PB
#undef WIN
#undef WUQ
#undef WUKV
#undef WO
#undef WPG
#undef WPLE
#undef H2F
#undef XB
#undef MIX
#undef H2B
#undef KV
#undef H1B
#undef Q
#undef WUP
#undef WDN
#undef VH
#undef GH
#undef EB
#undef CQ
#undef CKV
#undef QH
#undef HID
#undef ws
#undef FF
#undef UT
#undef DDK
}

extern "C" void kernel_launch(void* const* d_in, const int* in_sizes, int n_in, void* d_out, int out_size, void* d_ws, size_t ws_size, hipStream_t stream) {
    static int grid = 0;
    if (grid == 0) {
        if (n_in != 20 || in_sizes[0] != M * DM || out_size != M * DM || ws_size < WS_END) { fprintf(stderr, "kernel_launch: unexpected shapes (n_in %d, in0 %d, out %d, ws %zu); nothing launched\n", n_in, n_in > 0 ? in_sizes[0] : -1, out_size, ws_size); grid = -1; return; }
        int dev = 0, cus = 0, per_cu = 0;
        if (hipGetDevice(&dev) != hipSuccess || hipDeviceGetAttribute(&cus, hipDeviceAttributeMultiprocessorCount, dev) != hipSuccess) { grid = -1; return; }
        if (hipFuncSetAttribute((const void*)hymba_fwd, hipFuncAttributeMaxDynamicSharedMemorySize, LDS_BYTES) != hipSuccess) { fprintf(stderr, "kernel_launch: hipFuncSetAttribute failed\n"); grid = -1; return; }
        if (hipOccupancyMaxActiveBlocksPerMultiprocessor(&per_cu, (const void*)hymba_fwd, NWAVES * 64, LDS_BYTES) != hipSuccess || per_cu < 1) fprintf(stderr, "kernel_launch: occupancy query reports %d workgroups per CU\n", per_cu);
        (void)hipGetLastError();
        grid = cus;
    }
    if (grid < 0) return;
    if (hipMemsetAsync((char*)d_ws + WS_CTL, 0, CTL_ZERO_BYTES, stream) != hipSuccess) return;
    Args a{};
    for (int i = 0; i < 20; ++i) a.in[i] = (const float*)d_in[i];
    a.out = (float*)d_out; a.ws = (unsigned char*)d_ws;
#if PROBE_DUP >= 0
    a.ph_lo = 0; a.ph_hi = PROBE_DUP + 1;
    hipLaunchKernelGGL(hymba_fwd, dim3(grid), dim3(NWAVES * 64), LDS_BYTES, stream, a);
    (void)hipMemsetAsync((char*)d_ws + WS_CTL, 0, CTL_ZERO_BYTES, stream);
    a.ph_lo = PROBE_DUP; a.ph_hi = N_PHASES;
    hipLaunchKernelGGL(hymba_fwd, dim3(grid), dim3(NWAVES * 64), LDS_BYTES, stream, a);
#elif MK_ONE_LAUNCH
    a.ph_lo = 0; a.ph_hi = N_PHASES;
    hipLaunchKernelGGL(hymba_fwd, dim3(grid), dim3(NWAVES * 64), LDS_BYTES, stream, a);
#else
    for (int li = 0; li < N_PHASES; ++li) { a.ph_lo = li; a.ph_hi = li + 1; hipLaunchKernelGGL(hymba_fwd, dim3(grid), dim3(NWAVES * 64), LDS_BYTES, stream, a); }
#endif
}
```
